# Optimizing an MI355X kernel written in HIP

```python
import jax, jax.numpy as jnp
from jax import lax
import numpy as np

D_MODEL = 2048
BATCH = 1
SEQ = 16384
DEPTH = 1

CHUNK = 64
SGU_BLOCK = 128
SGU_HEADS = 8
SGU_WIDTH = D_MODEL
SGU_HEAD_DIM = SGU_WIDTH // SGU_HEADS
POOL_WINDOWS = (2, 4, 8, 16)
POOL_GROUPS = len(POOL_WINDOWS)
POOL_WIDTH = D_MODEL
POOL_GROUP_DIM = POOL_WIDTH // POOL_GROUPS
N_BRANCHES = 2
D_FF = 5632
IN_COLS = 2 * SGU_WIDTH + POOL_WIDTH + N_BRANCHES * D_MODEL
RMS_EPS = 1e-6
LN_EPS = 1e-5

kernel_name = "hybrid_sgu_pool_gated_macaron"


def _rmsnorm(x, g):
    xf = x.astype(jnp.float32)
    y = xf * lax.rsqrt(jnp.mean(xf * xf, axis=-1, keepdims=True) + RMS_EPS)
    return (y * g.astype(jnp.float32)).astype(x.dtype)


def _layernorm(x, g, b):
    xf = x.astype(jnp.float32)
    mu = jnp.mean(xf, axis=-1, keepdims=True)
    var = jnp.mean(jnp.square(xf - mu), axis=-1, keepdims=True)
    y = (xf - mu) * lax.rsqrt(var + LN_EPS)
    return (y * g.astype(jnp.float32) + b.astype(jnp.float32)).astype(x.dtype)


def _swiglu(x, w_in, w_out):
    gate, up = jnp.split(x @ w_in, 2, axis=-1)
    return (jax.nn.silu(gate) * up) @ w_out


def _spatial_gating(z, ln_g, ln_b, w_s, b_s):
    bsz, s_len, _ = z.shape
    u, v = jnp.split(jax.nn.gelu(z, approximate=False), 2, axis=-1)
    v = _layernorm(v, ln_g, ln_b)
    v = v.reshape(bsz, s_len // SGU_BLOCK, SGU_BLOCK, SGU_HEADS, SGU_HEAD_DIM)
    pos = jnp.arange(SGU_BLOCK)
    mask = (pos[None, :] // CHUNK) <= (pos[:, None] // CHUNK)
    w = w_s * mask.astype(w_s.dtype)[None]
    s = jnp.einsum('hij,bnjhd->bnihd', w, v) + b_s.T[:, :, None]
    return u * s.reshape(bsz, s_len, SGU_WIDTH)


def _multiscale_pool(p, pool_w, pool_scale):
    bsz, s_len, _ = p.shape
    pf = p.astype(jnp.float32)
    csum = jnp.concatenate([jnp.zeros((bsz, 1, POOL_WIDTH), jnp.float32),
                            jnp.cumsum(pf, axis=1)], axis=1)
    upper = csum[:, 1:]
    t = jnp.arange(s_len)
    outs = []
    for k, w in enumerate(POOL_WINDOWS):
        sl = slice(k * POOL_GROUP_DIM, (k + 1) * POOL_GROUP_DIM)
        lower = jnp.pad(csum[:, :s_len + 1 - w, sl], ((0, 0), (w - 1, 0), (0, 0)))
        cnt = jnp.minimum(t + 1, w).astype(jnp.float32)[None, :, None]
        outs.append((upper[..., sl] - lower) / cnt - pf[..., sl])
    pooled = jnp.stack(outs, axis=2).astype(p.dtype)
    mixed = jnp.einsum('bsgc,gcd->bsgd', pooled, pool_w)
    return mixed.reshape(bsz, s_len, POOL_WIDTH) * pool_scale


def setup_inputs(seed: int = 0) -> dict:
    key = jax.random.key(seed)
    ks = jax.random.split(key, 24)
    f32 = jnp.float32

    def nrm(k, shape, fan_in):
        return jax.random.normal(k, shape, f32) * (fan_in ** -0.5)

    def gain(k, shape):
        return 1.0 + 0.02 * jax.random.normal(k, shape, f32)

    return {
        "x": jax.random.normal(ks[0], (BATCH, SEQ, D_MODEL), f32),
        "ffn1_norm": gain(ks[1], (D_MODEL,)),
        "ffn1_w_in": nrm(ks[2], (D_MODEL, 2 * D_FF), D_MODEL),
        "ffn1_w_out": nrm(ks[3], (D_FF, D_MODEL), D_FF),
        "mix_norm": gain(ks[4], (D_MODEL,)),
        "w_in": nrm(ks[5], (D_MODEL, IN_COLS), D_MODEL),
        "b_in": 0.02 * jax.random.normal(ks[6], (IN_COLS,), f32),
        "sgu_ln_g": gain(ks[7], (SGU_WIDTH,)),
        "sgu_ln_b": 0.02 * jax.random.normal(ks[8], (SGU_WIDTH,), f32),
        "sgu_w_s": nrm(ks[9], (SGU_HEADS, SGU_BLOCK, SGU_BLOCK), SGU_BLOCK),
        "sgu_b_s": gain(ks[10], (SGU_HEADS, SGU_BLOCK)),
        "pool_w": nrm(ks[11], (POOL_GROUPS, POOL_GROUP_DIM, POOL_GROUP_DIM), POOL_GROUP_DIM),
        "pool_scale": gain(ks[12], (POOL_WIDTH,)),
        "w_branch_a": nrm(ks[13], (SGU_WIDTH, D_MODEL), SGU_WIDTH),
        "w_branch_b": nrm(ks[14], (POOL_WIDTH, D_MODEL), POOL_WIDTH),
        "w_out": nrm(ks[15], (D_MODEL, D_MODEL), D_MODEL),
        "ffn2_norm": gain(ks[16], (D_MODEL,)),
        "ffn2_w_in": nrm(ks[17], (D_MODEL, 2 * D_FF), D_MODEL),
        "ffn2_w_out": nrm(ks[18], (D_FF, D_MODEL), D_FF),
        "final_norm": gain(ks[19], (D_MODEL,)),
    }


def reference(x, ffn1_norm, ffn1_w_in, ffn1_w_out, mix_norm, w_in, b_in,
              sgu_ln_g, sgu_ln_b, sgu_w_s, sgu_b_s, pool_w, pool_scale,
              w_branch_a, w_branch_b, w_out, ffn2_norm, ffn2_w_in, ffn2_w_out,
              final_norm):
    h = x
    for _ in range(DEPTH):
        h = h + 0.5 * _swiglu(_rmsnorm(h, ffn1_norm), ffn1_w_in, ffn1_w_out)

        n = _rmsnorm(h, mix_norm)
        proj = n @ w_in + b_in
        o_a = 2 * SGU_WIDTH
        o_b = o_a + POOL_WIDTH
        z_a = proj[..., :o_a]
        z_b = proj[..., o_a:o_b]
        gate_a = jax.nn.sigmoid(proj[..., o_b:o_b + D_MODEL])
        gate_b = jax.nn.sigmoid(proj[..., o_b + D_MODEL:])

        y_a = _spatial_gating(z_a, sgu_ln_g, sgu_ln_b, sgu_w_s, sgu_b_s) @ w_branch_a
        y_b = _multiscale_pool(z_b, pool_w, pool_scale) @ w_branch_b
        merged = gate_a * y_a + gate_b * y_b
        h = h + merged @ w_out

        h = h + 0.5 * _swiglu(_rmsnorm(h, ffn2_norm), ffn2_w_in, ffn2_w_out)
    return _rmsnorm(h, final_norm).astype(x.dtype)
```

```cpp
#include <hip/hip_runtime.h>
#include <hip/hip_cooperative_groups.h>
#include <cstdio>
#include <cstdint>
namespace cg = cooperative_groups;
namespace pg8 {
#define PG8_LAS __attribute__((address_space(3)))
typedef unsigned short bf16_t;
typedef short bf16x8 __attribute__((ext_vector_type(8)));
typedef float f32x4 __attribute__((ext_vector_type(4)));
typedef unsigned u32x4 __attribute__((ext_vector_type(4)));
constexpr int BM = 256, BK = 64, HALF = 128, HTB = HALF * BK * 2  , STAGE_BYTES = 8 * HTB, NXCD = 8, WGM = 8;

__host__ __device__ __forceinline__ int lds_byte(int r, int c) { const int st = (r >> 4) * 2 + (c >> 5), rr = r & 15, cc = c & 31, ob = rr * 64 + cc * 2; return st * 1024 + (ob ^ (((ob >> 9) & 1) << 5)); }
__host__ __device__ __forceinline__ void stage_rc(int b, int& R, int& C) { const int st = b / 1024, sb = b % 1024, swz = sb ^ (((sb >> 9) & 1) << 5); R = (st >> 1) * 16 + swz / 64; C = (st & 1) * 32 + (swz % 64) / 2; }
__host__ __device__ __forceinline__ int perm32(int rho) { const int n = rho >> 4, i = rho & 15; return 8 * (i >> 2) + 4 * n + (i & 3); }

struct Unit { int pm, pn; };
struct Gemm { const bf16_t* A; const bf16_t* Bt; int M, N, K, lda, ldb, gshift, gk; };

struct StaticOrder {
    int nM, nN, nwg, G, c;
    __host__ __device__ void init(int M, int N, int G_, int c_) { nM = M / BM; nN = N / BM; nwg = nM * nN; G = G_; c = c_; }
    __host__ __device__ bool next(int i, Unit& u) const {
        const long L = (long)i * G + c; if (L >= nwg) return false;
        int wgid = (int)L; { const int q = nwg / NXCD, r = nwg % NXCD, xcd = wgid % NXCD, off = wgid / NXCD; wgid = (xcd < r ? xcd * (q + 1) : r * (q + 1) + (xcd - r) * q) + off; }
        const int nig = WGM * nN, gid = wgid / nig, fm = gid * WGM, gsz = (nM - fm) < WGM ? (nM - fm) : WGM;
        u.pm = fm + ((wgid % nig) % gsz); u.pn = (wgid % nig) / gsz; return true;
    }
    __device__ __forceinline__ void a_ready(const Unit&) const {}
    __device__ __forceinline__ void done(const Unit&) const {}
};

__device__ __forceinline__ unsigned cvt_pk_bf16(float lo, float hi) { unsigned r; asm volatile("v_cvt_pk_bf16_f32 %0, %1, %2" : "=v"(r) : "v"(lo), "v"(hi)); return r; }
typedef float f32x2 __attribute__((ext_vector_type(2)));
__device__ __forceinline__ f32x2 gelu_pk(f32x2 v) {
    const f32x2 av = __builtin_elementwise_abs(v), d = av * 0.2316418882f + 1.0f;
    f32x2 t; t.x = __builtin_amdgcn_rcpf(d.x); t.y = __builtin_amdgcn_rcpf(d.y);
    f32x2 q = t * 0.5307027145f + (-0.7265760135f); q = q * t + 0.7107068705f; q = q * t + (-0.142248368f); q = q * t + 0.127414796f; q = q * t;
    const f32x2 s = (v * v) * (-0.72134752044f);
    f32x2 e; e.x = __builtin_amdgcn_exp2f(s.x); e.y = __builtin_amdgcn_exp2f(s.y);
    const f32x2 m = v * (q * e), r = v - m;
    f32x2 o; o.x = v.x < 0.f ? m.x : r.x; o.y = v.y < 0.f ? m.y : r.y; return o;
}

__device__ __forceinline__ float bf_lo(unsigned w) { return __uint_as_float(w << 16); }
__device__ __forceinline__ float bf_hi(unsigned w) { return __uint_as_float(w & 0xffff0000u); }
__device__ __forceinline__ float fast_sigmoid(float x) { return __builtin_amdgcn_rcpf(1.0f + __builtin_amdgcn_exp2f(x * -1.44269504089f)); }

__device__ __forceinline__ float row_rstd(const float* slots, int row, int fq) {
    const f32x4* sp = (const f32x4*)(slots + (size_t)row * 32 + fq * 8); const f32x4 a = sp[0], b = sp[1]; float q = ((a[0] + a[1]) + (a[2] + a[3])) + ((b[0] + b[1]) + (b[2] + b[3]));
    q += __shfl_xor(q, 16); q += __shfl_xor(q, 32); return 1.0f / sqrtf(q * (1.0f / 2048.0f) + 1e-6f);
}
__device__ __forceinline__ void row_rstd4(const float* slots, int row0, int fq, float (&rs)[4]) {
    f32x4 a[4], b[4];
#pragma unroll
    for (int m = 0; m < 4; ++m) { const f32x4* sp = (const f32x4*)(slots + (size_t)(row0 + 16 * m) * 32 + fq * 8); a[m] = sp[0]; b[m] = sp[1]; }
#pragma unroll
    for (int m = 0; m < 4; ++m) { float q = ((a[m][0] + a[m][1]) + (a[m][2] + a[m][3])) + ((b[m][0] + b[m][1]) + (b[m][2] + b[m][3]));
        q += __shfl_xor(q, 16); q += __shfl_xor(q, 32); rs[m] = 1.0f / sqrtf(q * (1.0f / 2048.0f) + 1e-6f); }
}
#define PG8_EPI_DRAIN() asm volatile("s_waitcnt vmcnt(0)" ::: "memory")
template <bool RS> struct EpiSwiglu {
    static constexpr bool PERM = true, AFTER_DRAIN = false;
    bf16_t* O; int ldc; const float* slots; const PG8_LAS float* rtab; int pm0;
    __device__ __forceinline__ void operator()(const f32x4 (&acc)[2][2][4][2], const Unit& u, int wr, int wc, int fr, int fq) const {
        const int row0 = u.pm * BM + wr * 64 + fr, col0 = u.pn * HALF + wc * 32 + 8 * fq;
#pragma unroll
        for (int ai = 0; ai < 2; ++ai) { float rs4[4] = {1.f, 1.f, 1.f, 1.f};
            if (RS) { if (u.pm == pm0) {
#pragma unroll
                for (int m = 0; m < 4; ++m) rs4[m] = rtab[wr * 64 + fr + ai * HALF + m * 16]; } else row_rstd4(slots, row0 + ai * HALF, fq, rs4); }
            u32x4 w[4];
#pragma unroll
            for (int m = 0; m < 4; ++m) {
                f32x4 g0 = acc[ai][0][m][0], g1 = acc[ai][0][m][1], u0 = acc[ai][1][m][0], u1 = acc[ai][1][m][1];
                if (RS) { const float rs = rs4[m]; g0 = g0 * rs; g1 = g1 * rs; u0 = u0 * rs; u1 = u1 * rs; }
#pragma unroll
                for (int j = 0; j < 4; ++j) { g0[j] = g0[j] * fast_sigmoid(g0[j]) * u0[j]; g1[j] = g1[j] * fast_sigmoid(g1[j]) * u1[j]; }
                w[m].x = cvt_pk_bf16(g0[0], g0[1]); w[m].y = cvt_pk_bf16(g0[2], g0[3]); w[m].z = cvt_pk_bf16(g1[0], g1[1]); w[m].w = cvt_pk_bf16(g1[2], g1[3]); }
            if (ai == 0) PG8_EPI_DRAIN();
#pragma unroll
            for (int m = 0; m < 4; ++m) *(u32x4*)(O + (size_t)(row0 + ai * HALF + m * 16) * ldc + col0) = w[m]; }
    }
};
template <bool NORM> struct EpiResid {
    static constexpr bool PERM = false, AFTER_DRAIN = false;
    const float* res; float* out; int ldc; float alpha; bf16_t* xn; float* slots;
    __device__ __forceinline__ void operator()(const f32x4 (&acc)[2][2][4][2], const Unit& u, int wr, int wc, int fr, int fq) const {
        const int row0 = u.pm * BM + wr * 64 + fr, col0 = u.pn * BM + wc * 32 + 4 * fq;
#pragma unroll
        for (int ai = 0; ai < 2; ++ai)
#pragma unroll
            for (int mp = 0; mp < 1; ++mp) { f32x4 r[4][2][2];
#pragma unroll
                for (int mm = 0; mm < 4; ++mm)
#pragma unroll
                    for (int bj = 0; bj < 2; ++bj)
#pragma unroll
                        for (int n = 0; n < 2; ++n) r[mm][bj][n] = *(const f32x4*)(res + (size_t)(row0 + ai * HALF + mm * 16) * ldc + col0 + bj * HALF + n * 16);
#pragma unroll
                for (int mm = 0; mm < 4; ++mm) { const int m = mm, row = row0 + ai * HALF + m * 16; const size_t off = (size_t)row * ldc + col0; float q = 0.f;
#pragma unroll
                    for (int bj = 0; bj < 2; ++bj)
#pragma unroll
                        for (int n = 0; n < 2; ++n) { const f32x4 o = r[mm][bj][n] + acc[ai][bj][m][n] * alpha; if (ai == 0 && mm == 0 && bj == 0 && n == 0) PG8_EPI_DRAIN(); *(f32x4*)(out + off + bj * HALF + n * 16) = o;
                            if (NORM) { q += (o[0] * o[0] + o[1] * o[1]) + (o[2] * o[2] + o[3] * o[3]); typedef unsigned u32x2 __attribute__((ext_vector_type(2)));
                                u32x2 w; w.x = cvt_pk_bf16(o[0], o[1]); w.y = cvt_pk_bf16(o[2], o[3]); *(u32x2*)(xn + off + bj * HALF + n * 16) = w; } }
                    if (NORM) { q += __shfl_xor(q, 16); q += __shfl_xor(q, 32); if (fq == 0) slots[(size_t)row * 32 + u.pn * 4 + wc] = q; } }
                asm volatile("" ::: "memory"); }
    }
};
struct EpiProj {
    static constexpr bool PERM = true, AFTER_DRAIN = false;
    bf16_t *U, *V, *ZB, *GA, *GB; const float* bias; float* stats; const float* slots; const PG8_LAS float* rtab; int pm0;
    __device__ __forceinline__ void operator()(const f32x4 (&acc)[2][2][4][2], const Unit& u, int wr, int wc, int fr, int fq) const {
        const int grp = u.pn >> 3, row0 = u.pm * BM + wr * 64 + fr, col0 = (u.pn & 7) * BM + wc * 32 + 8 * fq, bcol0 = u.pn * BM + wc * 32 + 8 * fq;
        bf16_t* base = grp == 0 ? U : grp == 1 ? V : grp == 2 ? ZB : grp == 3 ? GA : GB;
        f32x4 bv[2][2];
#pragma unroll
        for (int bj = 0; bj < 2; ++bj)
#pragma unroll
            for (int n = 0; n < 2; ++n) bv[bj][n] = *(const f32x4*)(bias + bcol0 + bj * HALF + 4 * n);
#pragma unroll
        for (int ai = 0; ai < 2; ++ai) { float rs4[4];
            if (u.pm == pm0) {
#pragma unroll
                for (int m = 0; m < 4; ++m) rs4[m] = rtab[wr * 64 + fr + ai * HALF + m * 16]; } else row_rstd4(slots, row0 + ai * HALF, fq, rs4);
#pragma unroll
            for (int m = 0; m < 4; ++m) { const int row = row0 + ai * HALF + m * 16; bf16_t* rowp = base + (size_t)row * 2048 + col0; float s = 0.f, q = 0.f; const float rs = rs4[m];
#pragma unroll
                for (int bj = 0; bj < 2; ++bj) { f32x4 v0 = acc[ai][bj][m][0] * rs + bv[bj][0], v1 = acc[ai][bj][m][1] * rs + bv[bj][1];
                    if (grp < 2) { f32x2 a = gelu_pk((f32x2){v0[0], v0[1]}), b = gelu_pk((f32x2){v0[2], v0[3]}), c = gelu_pk((f32x2){v1[0], v1[1]}), d = gelu_pk((f32x2){v1[2], v1[3]});
                        v0 = (f32x4){a.x, a.y, b.x, b.y}; v1 = (f32x4){c.x, c.y, d.x, d.y};
                        s += ((v0[0] + v0[1]) + (v0[2] + v0[3])) + ((v1[0] + v1[1]) + (v1[2] + v1[3]));
                        q += ((v0[0] * v0[0] + v0[1] * v0[1]) + (v0[2] * v0[2] + v0[3] * v0[3])) + ((v1[0] * v1[0] + v1[1] * v1[1]) + (v1[2] * v1[2] + v1[3] * v1[3])); }
                    else if (grp >= 3) {
#pragma unroll
                        for (int j = 0; j < 4; ++j) { v0[j] = fast_sigmoid(v0[j]); v1[j] = fast_sigmoid(v1[j]); } }
                    u32x4 w; w.x = cvt_pk_bf16(v0[0], v0[1]); w.y = cvt_pk_bf16(v0[2], v0[3]); w.z = cvt_pk_bf16(v1[0], v1[1]); w.w = cvt_pk_bf16(v1[2], v1[3]);
                    if (ai == 0 && m == 0 && bj == 0) PG8_EPI_DRAIN(); *(u32x4*)(rowp + bj * HALF) = w; }
                if (grp == 1) { s += __shfl_xor(s, 16); s += __shfl_xor(s, 32); q += __shfl_xor(q, 16); q += __shfl_xor(q, 32);
                    if (fq == 0) *(f32x2*)(stats + ((size_t)row * 32 + (u.pn & 7) * 4 + wc) * 2) = (f32x2){s, q}; } } }
    }
};
struct EpiScale {
    static constexpr bool PERM = true, AFTER_DRAIN = false;
    bf16_t* O; const float* scale;
    __device__ __forceinline__ void operator()(const f32x4 (&acc)[2][2][4][2], const Unit& u, int wr, int wc, int fr, int fq) const {
        const int row0 = u.pm * BM + wr * 64 + fr, col0 = u.pn * BM + wc * 32 + 8 * fq;
        f32x4 sv[2][2];
#pragma unroll
        for (int bj = 0; bj < 2; ++bj)
#pragma unroll
            for (int n = 0; n < 2; ++n) sv[bj][n] = *(const f32x4*)(scale + col0 + bj * HALF + 4 * n);
#pragma unroll
        for (int ai = 0; ai < 2; ++ai)
#pragma unroll
            for (int m = 0; m < 4; ++m) { bf16_t* rowp = O + (size_t)(row0 + ai * HALF + m * 16) * 2048 + col0;
#pragma unroll
                for (int bj = 0; bj < 2; ++bj) { const f32x4 v0 = acc[ai][bj][m][0] * sv[bj][0], v1 = acc[ai][bj][m][1] * sv[bj][1];
                    u32x4 w; w.x = cvt_pk_bf16(v0[0], v0[1]); w.y = cvt_pk_bf16(v0[2], v0[3]); w.z = cvt_pk_bf16(v1[0], v1[1]); w.w = cvt_pk_bf16(v1[2], v1[3]);
                    if (ai == 0 && m == 0 && bj == 0) PG8_EPI_DRAIN(); *(u32x4*)(rowp + bj * HALF) = w; } }
    }
};
template <bool ADD> struct EpiGate {
    static constexpr bool PERM = true, AFTER_DRAIN = false;
    const bf16_t* G; const bf16_t* P; bf16_t* O;
    __device__ __forceinline__ void operator()(const f32x4 (&acc)[2][2][4][2], const Unit& u, int wr, int wc, int fr, int fq) const {
        const int row0 = u.pm * BM + wr * 64 + fr, col0 = u.pn * BM + wc * 32 + 8 * fq;
#pragma unroll
        for (int ai = 0; ai < 2; ++ai)
#pragma unroll
            for (int mp = 0; mp < 1; ++mp) { u32x4 gw[4][2], pw[4][2];
#pragma unroll
                for (int mm = 0; mm < 4; ++mm)
#pragma unroll
                    for (int bj = 0; bj < 2; ++bj) { const size_t off = (size_t)(row0 + ai * HALF + mm * 16) * 2048 + col0 + bj * HALF; gw[mm][bj] = *(const u32x4*)(G + off); if (ADD) pw[mm][bj] = *(const u32x4*)(P + off); }
#pragma unroll
                for (int mm = 0; mm < 4; ++mm)
#pragma unroll
                    for (int bj = 0; bj < 2; ++bj) { const int m = mm; const size_t off = (size_t)(row0 + ai * HALF + m * 16) * 2048 + col0 + bj * HALF; const u32x4 g4 = gw[mm][bj]; f32x4 v0 = acc[ai][bj][m][0], v1 = acc[ai][bj][m][1];
                        v0 = v0 * (f32x4){bf_lo(g4.x), bf_hi(g4.x), bf_lo(g4.y), bf_hi(g4.y)}; v1 = v1 * (f32x4){bf_lo(g4.z), bf_hi(g4.z), bf_lo(g4.w), bf_hi(g4.w)};
                        if (ADD) { const u32x4 p4 = pw[mm][bj];
                            v0 = v0 + (f32x4){bf_lo(p4.x), bf_hi(p4.x), bf_lo(p4.y), bf_hi(p4.y)}; v1 = v1 + (f32x4){bf_lo(p4.z), bf_hi(p4.z), bf_lo(p4.w), bf_hi(p4.w)}; }
                        u32x4 w; w.x = cvt_pk_bf16(v0[0], v0[1]); w.y = cvt_pk_bf16(v0[2], v0[3]); w.z = cvt_pk_bf16(v1[0], v1[1]); w.w = cvt_pk_bf16(v1[2], v1[3]);
                        if (ai == 0 && mm == 0 && bj == 0) PG8_EPI_DRAIN(); *(u32x4*)(O + off) = w; }
                asm volatile("" ::: "memory"); }
    }
};

template <class Epi, class Sched, bool ALIGN_EPI = false, bool SP2 = false>
__device__ __forceinline__ void gemm_phase(PG8_LAS unsigned char* lds, const Gemm g, const Sched& S, const Epi& E, const int wid) {
    int lane0 = (int)__builtin_amdgcn_mbcnt_hi(~0u, __builtin_amdgcn_mbcnt_lo(~0u, 0u)); asm volatile("" : "+v"(lane0));
    const int lane = lane0, tid = wid * 64 + lane, wr = wid >> 2, wc = wid & 3, fr = lane & 15, fq = lane >> 4;
    const int K = g.K, nt = K / BK;
    unsigned voffA[2], voffB[2];
#pragma unroll
    for (int i = 0; i < 2; ++i) { int R, C; stage_rc(tid * 16 + i * 8192, R, C); const int Rb = Epi::PERM ? ((R & ~31) + perm32(R & 31)) : R;
        voffA[i] = (unsigned)(R * g.lda + C) * 2u; voffB[i] = (unsigned)(Rb * g.ldb + C) * 2u; }
    const size_t kstep = (size_t)(BK * 2);
    const size_t hstepA = (size_t)HALF * g.lda * 2, hstepB = (size_t)HALF * g.ldb * 2;
    const size_t tstepA = 2 * hstepA, tstepB = 2 * hstepB;
    const unsigned ldsw = (unsigned)wid * 1024u;
    const int aoff = lds_byte(wr * 64 + fr, fq * 8), boff = lds_byte(wc * 32 + fr, fq * 8);
#define PG8_SA(b, h) (((b) * 2 + (h)) * HTB)
#define PG8_SB(b, h) ((4 + (b) * 2 + (h)) * HTB)
#define PG8_STAGE(bufoff, gbase, voff) do { _Pragma("unroll") for (int _i = 0; _i < 2; ++_i) \
        __builtin_amdgcn_global_load_lds((const unsigned*)((const char*)(gbase) + (voff)[_i]), (PG8_LAS unsigned*)(lds + (bufoff) + ldsw + _i * 8192), 16, 0, 0); } while (0)
#define PG8_LDA(dst, b, h) do { _Pragma("unroll") for (int m = 0; m < 4; ++m) _Pragma("unroll") for (int k = 0; k < 2; ++k) dst[m][k] = *(const PG8_LAS bf16x8*)(lds + PG8_SA(b, h) + aoff + m * 2048 + k * 1024); } while (0)
#define PG8_LDB(dst, b, h) do { _Pragma("unroll") for (int n = 0; n < 2; ++n) _Pragma("unroll") for (int k = 0; k < 2; ++k) dst[n][k] = *(const PG8_LAS bf16x8*)(lds + PG8_SB(b, h) + boff + n * 2048 + k * 1024); } while (0)
#define PG8_MMA(ai, bj, At, Bt) do { __builtin_amdgcn_s_setprio(1); _Pragma("unroll") for (int k = 0; k < 2; ++k) _Pragma("unroll") for (int m = 0; m < 4; ++m) _Pragma("unroll") for (int nn = 0; nn < 2; ++nn) { const int n = (m & 1) ? 1 - nn : nn;     \
        acc[ai][bj][m][n] = __builtin_amdgcn_mfma_f32_16x16x32_bf16(Bt[n][k], At[m][k], acc[ai][bj][m][n], 0, 0, 0); } __builtin_amdgcn_s_setprio(0); } while (0)
#define PG8_WAIT_V8_UNLESS(c) asm volatile("s_cmp_lg_u32 %0, 0\n\ts_cbranch_scc1 1\n\ts_waitcnt vmcnt(8)" :: "s"(__builtin_amdgcn_readfirstlane((unsigned)(c))) : "memory", "scc")
#define PG8_WAIT_V(n) asm volatile("s_waitcnt vmcnt(" #n ")" ::: "memory")
#define PG8_WAIT_L(n) asm volatile("s_waitcnt lgkmcnt(" #n ")" ::: "memory")
#define PG8_BAR __builtin_amdgcn_s_barrier()
#define PG8_SCHED __builtin_amdgcn_sched_barrier(0)
    Unit cur, nxt; int ui = 0;
    if (!S.next(0, cur)) return;
    f32x4 acc[2][2][4][2];
#pragma unroll
    for (int a = 0; a < 2; ++a)
#pragma unroll
        for (int b = 0; b < 2; ++b)
#pragma unroll
            for (int m = 0; m < 4; ++m)
#pragma unroll
                for (int n = 0; n < 2; ++n) acc[a][b][m][n] = (f32x4){0.f, 0.f, 0.f, 0.f};
    bf16x8 At[4][2], B0[2][2], B1[2][2];
    const char* cA = (const char*)g.A + (size_t)cur.pm * tstepA + (size_t)((cur.pn >> g.gshift) * g.gk) * 2; const char* cB = (const char*)g.Bt + (size_t)cur.pn * tstepB;
    S.a_ready(cur);
    if constexpr (SP2) {
        PG8_STAGE(PG8_SB(0, 0), cB, voffB); PG8_STAGE(PG8_SB(0, 1), cB + hstepB, voffB); PG8_STAGE(PG8_SA(0, 0), cA, voffA); PG8_STAGE(PG8_SA(0, 1), cA + hstepA, voffA);
        if (wr == 1) PG8_BAR;
        PG8_WAIT_V(2); PG8_BAR;
        PG8_STAGE(PG8_SB(1, 0), cB + kstep, voffB); PG8_STAGE(PG8_SA(1, 0), cA + kstep, voffA); PG8_STAGE(PG8_SB(1, 1), cB + hstepB + kstep, voffB);
        PG8_WAIT_V(6); PG8_BAR;
    } else {
        PG8_STAGE(PG8_SB(0, 0), cB, voffB); PG8_STAGE(PG8_SA(0, 0), cA, voffA); PG8_STAGE(PG8_SB(0, 1), cB + hstepB, voffB); PG8_STAGE(PG8_SA(0, 1), cA + hstepA, voffA);
        if (wr == 1) PG8_BAR;
        PG8_WAIT_V(4); PG8_BAR;
        PG8_STAGE(PG8_SB(1, 0), cB + kstep, voffB); PG8_STAGE(PG8_SA(1, 0), cA + kstep, voffA); PG8_STAGE(PG8_SB(1, 1), cB + hstepB + kstep, voffB);
        PG8_WAIT_V(6); PG8_BAR;
    }
    for (;;) {
        const bool has_next = S.next(ui + 1, nxt);
        const char* nA = has_next ? (const char*)g.A + (size_t)nxt.pm * tstepA + (size_t)((nxt.pn >> g.gshift) * g.gk) * 2 : cA; const char* nB = has_next ? (const char*)g.Bt + (size_t)nxt.pn * tstepB : cB;
        for (int t = 0; t < nt; t += 2) {
            const bool last = (t == nt - 2);
            const char* a1 = cA + (size_t)(t + 1) * kstep;
            const char* a2 = last ? nA : cA + (size_t)(t + 2) * kstep; const char* b2 = last ? nB : cB + (size_t)(t + 2) * kstep;
            const char* a3 = a2 + kstep; const char* b3 = b2 + kstep;
            if (last && has_next) S.a_ready(nxt);
            if constexpr (SP2) {
            const bool fresh = (t == 0) && (ui > 0);
            PG8_LDB(B0, 0, 0); PG8_LDB(B1, 0, 1); PG8_SCHED; PG8_LDA(At, 0, 0); PG8_STAGE(PG8_SA(1, 1), a1 + hstepA, voffA);
            PG8_WAIT_V8_UNLESS(fresh); PG8_WAIT_L(0); PG8_BAR; PG8_MMA(0, 0, At, B0); PG8_MMA(0, 1, At, B1); PG8_BAR; PG8_SCHED;
            PG8_LDA(At, 0, 1); PG8_STAGE(PG8_SB(0, 0), b2, voffB); PG8_STAGE(PG8_SB(0, 1), b2 + hstepB, voffB); PG8_STAGE(PG8_SA(0, 0), a2, voffA);
            PG8_WAIT_V8_UNLESS(fresh); PG8_WAIT_L(0); PG8_BAR; PG8_MMA(1, 0, At, B0); PG8_MMA(1, 1, At, B1); PG8_BAR; PG8_SCHED;
            PG8_LDB(B0, 1, 0); PG8_LDB(B1, 1, 1); PG8_SCHED; PG8_LDA(At, 1, 0); PG8_STAGE(PG8_SA(0, 1), a2 + hstepA, voffA);
            PG8_WAIT_V(8); PG8_WAIT_L(0); PG8_BAR; PG8_MMA(0, 0, At, B0); PG8_MMA(0, 1, At, B1); PG8_BAR; PG8_SCHED;
            PG8_LDA(At, 1, 1); PG8_STAGE(PG8_SB(1, 0), b3, voffB); PG8_STAGE(PG8_SB(1, 1), b3 + hstepB, voffB); PG8_STAGE(PG8_SA(1, 0), a3, voffA);
            PG8_WAIT_V(8); PG8_WAIT_L(0); PG8_BAR; PG8_MMA(1, 0, At, B0); PG8_MMA(1, 1, At, B1); PG8_BAR; PG8_SCHED;
            } else {
            PG8_LDB(B0, 0, 0); PG8_SCHED; PG8_LDA(At, 0, 0); PG8_STAGE(PG8_SA(1, 1), a1 + hstepA, voffA);
            PG8_WAIT_L(8); PG8_BAR; PG8_WAIT_L(0); PG8_MMA(0, 0, At, B0); PG8_BAR; PG8_SCHED;
            PG8_LDB(B1, 0, 1); PG8_STAGE(PG8_SB(0, 0), b2, voffB);
            PG8_BAR; PG8_WAIT_L(0); PG8_MMA(0, 1, At, B1); PG8_BAR;
            PG8_LDA(At, 0, 1); PG8_STAGE(PG8_SA(0, 0), a2, voffA);
            PG8_BAR; PG8_WAIT_L(0); PG8_MMA(1, 0, At, B0); PG8_BAR; PG8_SCHED;
            PG8_STAGE(PG8_SB(0, 1), b2 + hstepB, voffB);
            PG8_WAIT_V(6); PG8_BAR; PG8_MMA(1, 1, At, B1); PG8_BAR;
            PG8_LDB(B0, 1, 0); PG8_SCHED; PG8_LDA(At, 1, 0); PG8_STAGE(PG8_SA(0, 1), a2 + hstepA, voffA);
            PG8_WAIT_L(8); PG8_BAR; PG8_WAIT_L(0); PG8_MMA(0, 0, At, B0); PG8_BAR; PG8_SCHED;
            PG8_LDB(B1, 1, 1); PG8_STAGE(PG8_SB(1, 0), b3, voffB);
            PG8_BAR; PG8_WAIT_L(0); PG8_MMA(0, 1, At, B1); PG8_BAR;
            PG8_LDA(At, 1, 1); PG8_STAGE(PG8_SA(1, 0), a3, voffA);
            PG8_BAR; PG8_WAIT_L(0); PG8_MMA(1, 0, At, B0); PG8_BAR; PG8_SCHED;
            PG8_STAGE(PG8_SB(1, 1), b3 + hstepB, voffB);
            PG8_WAIT_V(6); PG8_BAR; PG8_MMA(1, 1, At, B1); PG8_BAR;
            }
        }
        if constexpr (ALIGN_EPI) { if (wr == 0) PG8_BAR; }
        if constexpr (!Epi::AFTER_DRAIN) { E(acc, cur, wr, wc, fr, fq); S.done(cur); }
        if (!has_next) break;
#pragma unroll
        for (int a = 0; a < 2; ++a)
#pragma unroll
            for (int b = 0; b < 2; ++b)
#pragma unroll
                for (int m = 0; m < 4; ++m)
#pragma unroll
                    for (int n = 0; n < 2; ++n) acc[a][b][m][n] = (f32x4){0.f, 0.f, 0.f, 0.f};
        cur = nxt; cA = nA; cB = nB; ++ui;
        if constexpr (ALIGN_EPI) { if (wr == 1) PG8_BAR; }
    }
    PG8_WAIT_V(0);
    if constexpr (!ALIGN_EPI) { if (wr == 0) PG8_BAR; }
    PG8_BAR;
    if constexpr (Epi::AFTER_DRAIN) { E.fused(acc, cur, wr, wc, fr, fq, lds, wid, lane); S.done(cur); }
#undef PG8_SA
#undef PG8_SB
#undef PG8_STAGE
#undef PG8_LDA
#undef PG8_LDB
#undef PG8_MMA
#undef PG8_WAIT_V
#undef PG8_WAIT_L
#undef PG8_BAR
#undef PG8_SCHED
}
}

constexpr int NWAVES = 8;
constexpr int M = 16384, D = 2048, FF = 5632, NIN = 10240;
constexpr float RMS_EPS = 1e-6f, LN_EPS = 1e-5f;
#ifndef MK_PER_PHASE
#define MK_PER_PHASE 0
#endif
constexpr int N_PHASES = 11;

constexpr size_t MiB = 1u << 20;
constexpr size_t WS_STATS = 0;
constexpr size_t WS_SLOTS = 4 * MiB;
constexpr size_t WS_WIN = 6 * MiB;
constexpr size_t WS_WBA = 46 * MiB, WS_WBB = 54 * MiB, WS_WOUT = 62 * MiB;
constexpr size_t WS_WPOOL = 70 * MiB;
constexpr size_t WS_W1 = 72 * MiB;
constexpr size_t WS_W1O = WS_W1 + 44 * MiB;
constexpr size_t WS_XN = 138 * MiB;
constexpr size_t WS_BIG = 202 * MiB;
constexpr size_t WS_W2 = 458 * MiB, WS_W2O = WS_W2 + 44 * MiB;
constexpr size_t WS_BAR = 524 * MiB, BAR_BYTES = 16384;
constexpr size_t WS_END = 524 * MiB + 65536;

constexpr int RING_BYTES = 131072, RSTD_OFF = RING_BYTES + 64, LDS_BYTES = 133120;

#define LAS __attribute__((address_space(3)))
typedef unsigned short bf16;
typedef unsigned v4u __attribute__((ext_vector_type(4)));
typedef unsigned v2u __attribute__((ext_vector_type(2)));
typedef float f32x4 __attribute__((ext_vector_type(4)));
typedef float f32x2 __attribute__((ext_vector_type(2)));
typedef short bf16x8 __attribute__((ext_vector_type(8)));
#define LDS_WAIT() asm volatile("s_waitcnt lgkmcnt(0)" ::: "memory")
__device__ __forceinline__ unsigned pk2(float lo, float hi) { return pg8::cvt_pk_bf16(lo, hi); }
__device__ __forceinline__ float wave_sum(float v) {
#pragma unroll
    for (int o = 1; o < 64; o <<= 1) v += __shfl_xor(v, o);
    return v;
}

struct TItem { const float* src; bf16* dst; const float* gain; int ldn, ldk; };
__device__ __forceinline__ void t_load(const TItem& t, f32x4 (&r)[8], int lane) {
    const float* p = t.src + (size_t)(lane >> 3) * t.ldn + (lane & 7) * 4;
#pragma unroll
    for (int i = 0; i < 8; ++i) r[i] = __builtin_nontemporal_load((const f32x4*)(p + (size_t)(8 * i) * t.ldn));
}
__device__ __forceinline__ void t_store(const TItem& t, const f32x4 (&r)[8], LAS float* scr, int lane) {
#pragma unroll
    for (int i = 0; i < 8; ++i) { const int kk = 8 * i + (lane >> 3); const float gs = t.gain ? t.gain[kk] : 1.0f; LAS float* d = scr + kk * 33 + (lane & 7) * 4;
        d[0] = r[i].x * gs; d[1] = r[i].y * gs; d[2] = r[i].z * gs; d[3] = r[i].w * gs; }
    LDS_WAIT(); asm volatile("" ::: "memory");
    const int c = lane & 7;
#pragma unroll
    for (int j = 0; j < 4; ++j) { const int n = (lane >> 3) + 8 * j; const LAS float* q = scr + (8 * c) * 33 + n;
        v4u o; o.x = pk2(q[0 * 33], q[1 * 33]); o.y = pk2(q[2 * 33], q[3 * 33]); o.z = pk2(q[4 * 33], q[5 * 33]); o.w = pk2(q[6 * 33], q[7 * 33]);
        *(v4u*)(t.dst + (size_t)n * t.ldk + 8 * c) = o; }
    LDS_WAIT(); asm volatile("" ::: "memory");
}
__device__ __forceinline__ TItem t_plain(const float* W, int K, int N, bf16* WT, int it, const float* gain) {
    const int nblk = N / 32, kb = it / nblk, nb = it % nblk; TItem t; t.src = W + (size_t)(64 * kb) * N + 32 * nb; t.dst = WT + (size_t)(32 * nb) * K + 64 * kb; t.gain = gain ? gain + 64 * kb : nullptr; t.ldn = N; t.ldk = K; return t;
}
__device__ __forceinline__ TItem t_swiglu(const float* W, bf16* WT, int it, const float* gain) {
    constexpr int nblk = 2 * FF / 32; const int kb = it / nblk, nb = it % nblk; int n0 = 32 * nb, up = 0; if (n0 >= FF) { n0 -= FF; up = 128; }
    TItem t; t.src = W + (size_t)(64 * kb) * (2 * FF) + 32 * nb; t.dst = WT + (size_t)(256 * (n0 >> 7) + up + (n0 & 127)) * D + 64 * kb; t.gain = gain ? gain + 64 * kb : nullptr; t.ldn = 2 * FF; t.ldk = D; return t;
}
constexpr int IT_FFN_IN = (D / 64) * (2 * FF / 32), IT_FFN_OUT = (FF / 64) * (D / 32), IT_WIN = (D / 64) * (NIN / 32), IT_DD = (D / 64) * (D / 32), IT_POOL = (512 / 64) * (512 / 32);

template <bool OUT_F32> __device__ __forceinline__ void rms_rows(const float* src, const float* gain, void* dst, int gw, int NGW, int lane) {
    if (gw >= M) return;
    f32x4 v[8], nv[8];
#pragma unroll
    for (int j = 0; j < 8; ++j) v[j] = __builtin_nontemporal_load((const f32x4*)(src + (size_t)gw * D) + lane + 64 * j);
    for (int m = gw; m < M; m += NGW) {
        if (m + NGW < M) {
#pragma unroll
            for (int j = 0; j < 8; ++j) nv[j] = __builtin_nontemporal_load((const f32x4*)(src + (size_t)(m + NGW) * D) + lane + 64 * j); }
        float s = 0.f;
#pragma unroll
        for (int j = 0; j < 8; ++j) s += (v[j].x * v[j].x + v[j].y * v[j].y) + (v[j].z * v[j].z + v[j].w * v[j].w);
        const float rstd = 1.0f / sqrtf(wave_sum(s) * (1.f / D) + RMS_EPS);
#pragma unroll
        for (int j = 0; j < 8; ++j) { const f32x4 g = ((const f32x4*)gain)[lane + 64 * j]; const f32x4 o = v[j] * rstd * g;
            if (OUT_F32) ((f32x4*)((float*)dst + (size_t)m * D))[lane + 64 * j] = o;
            else { v2u w; w.x = pk2(o.x, o.y); w.y = pk2(o.z, o.w); ((v2u*)((bf16*)dst + (size_t)m * D))[lane + 64 * j] = w; } }
#pragma unroll
        for (int j = 0; j < 8; ++j) v[j] = nv[j];
    }
}

constexpr int SGU_WM_OFF = 0, SGU_WM_PITCH = 272, SGU_VT_OFF = 128 * SGU_WM_PITCH, SGU_VT_PITCH = 520, SGU_ST_OFF = SGU_VT_OFF + 128 * SGU_VT_PITCH;
static_assert(SGU_ST_OFF + 1024 <= RING_BYTES, "SGU LDS map");
__device__ __forceinline__ void sgu_phase(LAS unsigned char* lds, bf16* U, const bf16* V, const float* stats, const float* ln_g, const float* ln_b, const float* w_s, const float* b_s, int G, int bid, const int wid) {
    int lane0 = (int)__builtin_amdgcn_mbcnt_hi(~0u, __builtin_amdgcn_mbcnt_lo(~0u, 0u)); asm volatile("" : "+v"(lane0));
    const int lane = lane0, tid = wid * 64 + lane, fr = lane & 15, fq = lane >> 4;
    const int h = bid & 7;
#pragma unroll
    for (int it = 0; it < 8; ++it) { const int q = it * 512 + tid, i = q >> 5, j4 = (q & 31) * 4; f32x4 w = *(const f32x4*)(w_s + (size_t)h * 16384 + i * 128 + j4);
        if (i < 64 && j4 >= 64) w = (f32x4){0.f, 0.f, 0.f, 0.f};
        v2u o; o.x = pk2(w.x, w.y); o.y = pk2(w.z, w.w); *(LAS v2u*)(lds + SGU_WM_OFF + i * SGU_WM_PITCH + j4 * 2) = o; }
    const int c8 = tid & 31; const f32x4 g0 = *(const f32x4*)(ln_g + h * 256 + c8 * 8), g1 = *(const f32x4*)(ln_g + h * 256 + c8 * 8 + 4), b0 = *(const f32x4*)(ln_b + h * 256 + c8 * 8), b1 = *(const f32x4*)(ln_b + h * 256 + c8 * 8 + 4);
    LAS float* smu = (LAS float*)(lds + SGU_ST_OFF); LAS float* srs = smu + 128;
    v4u vn[8]; f32x4 sn[4];
#define SGU_PREFETCH(unit_) do { const size_t rb_ = (size_t)((unit_) >> 3) * 128; \
        _Pragma("unroll") for (int it = 0; it < 8; ++it) vn[it] = *(const v4u*)(V + (rb_ + it * 16 + (tid >> 5)) * 2048 + h * 256 + c8 * 8); \
        _Pragma("unroll") for (int k = 0; k < 4; ++k) sn[k] = *(const f32x4*)(stats + (rb_ + (tid >> 2)) * 64 + (tid & 3) * 16 + 4 * k); } while (0)
    if (bid < 1024) SGU_PREFETCH(bid);
    for (int unit = bid; unit < 1024; unit += G) {
        const int nb = unit >> 3; const size_t rowbase = (size_t)nb * 128;
        { float s = 0.f, q = 0.f;
#pragma unroll
            for (int k = 0; k < 4; ++k) { s += sn[k].x + sn[k].z; q += sn[k].y + sn[k].w; }
            s += __shfl_xor(s, 1); q += __shfl_xor(q, 1); s += __shfl_xor(s, 2); q += __shfl_xor(q, 2);
            const float mean = s * (1.f / 2048.f), var = fmaxf(q * (1.f / 2048.f) - mean * mean, 0.f);
            if ((tid & 3) == 0) { smu[tid >> 2] = mean; srs[tid >> 2] = 1.0f / sqrtf(var + LN_EPS); } }
        __syncthreads();
#pragma unroll
        for (int it = 0; it < 8; ++it) { const int j = it * 16 + (tid >> 5); const v4u vw = vn[it]; const float mu = smu[j], rs = srs[j];
            f32x4 x0 = (f32x4){pg8::bf_lo(vw.x), pg8::bf_hi(vw.x), pg8::bf_lo(vw.y), pg8::bf_hi(vw.y)}, x1 = (f32x4){pg8::bf_lo(vw.z), pg8::bf_hi(vw.z), pg8::bf_lo(vw.w), pg8::bf_hi(vw.w)};
            x0 = (x0 - mu) * rs * g0 + b0; x1 = (x1 - mu) * rs * g1 + b1;
            LAS v2u* dst = (LAS v2u*)(lds + SGU_VT_OFF + j * SGU_VT_PITCH + c8 * 16); v2u o0, o1; o0.x = pk2(x0.x, x0.y); o0.y = pk2(x0.z, x0.w); o1.x = pk2(x1.x, x1.y); o1.y = pk2(x1.z, x1.w); dst[0] = o0; dst[1] = o1; }
        __syncthreads();
        v2u uw[8][2];
#pragma unroll
        for (int m = 0; m < 8; ++m)
#pragma unroll
            for (int n = 0; n < 2; ++n) uw[m][n] = *(const v2u*)(U + (rowbase + 16 * m + fr) * 2048 + h * 256 + 32 * wid + 16 * n + 4 * fq);
        if (unit + G < 1024) SGU_PREFETCH(unit + G);
        f32x4 acc[8][2];
#pragma unroll
        for (int m = 0; m < 8; ++m) { acc[m][0] = (f32x4){0.f, 0.f, 0.f, 0.f}; acc[m][1] = (f32x4){0.f, 0.f, 0.f, 0.f}; }
#pragma unroll 1
        for (int ks = 0; ks < 4; ++ks) {
            bf16x8 vf[2];
#pragma unroll
            for (int n = 0; n < 2; ++n) { const LAS bf16* vp = (const LAS bf16*)(lds + SGU_VT_OFF + (32 * ks + 8 * fq) * SGU_VT_PITCH + (32 * wid + 16 * n + fr) * 2);
#pragma unroll
                for (int e = 0; e < 8; ++e) vf[n][e] = (short)vp[e * (SGU_VT_PITCH / 2)]; }
#pragma unroll
            for (int m = 0; m < 8; ++m) { const bf16x8 wf = *(const LAS bf16x8*)(lds + SGU_WM_OFF + (16 * m + fr) * SGU_WM_PITCH + (32 * ks + 8 * fq) * 2);
                acc[m][0] = __builtin_amdgcn_mfma_f32_16x16x32_bf16(vf[0], wf, acc[m][0], 0, 0, 0); acc[m][1] = __builtin_amdgcn_mfma_f32_16x16x32_bf16(vf[1], wf, acc[m][1], 0, 0, 0); }
        }
#pragma unroll
        for (int m = 0; m < 8; ++m) { const int i = 16 * m + fr; const float bs = b_s[h * 128 + i];
#pragma unroll
            for (int n = 0; n < 2; ++n) { bf16* up = U + (rowbase + i) * 2048 + h * 256 + 32 * wid + 16 * n + 4 * fq; const v2u u2 = uw[m][n]; const f32x4 s = acc[m][n] + bs;
                v2u o; o.x = pk2(pg8::bf_lo(u2.x) * s.x, pg8::bf_hi(u2.x) * s.y); o.y = pk2(pg8::bf_lo(u2.y) * s.z, pg8::bf_hi(u2.y) * s.w); *(v2u*)up = o; } }
        __syncthreads();
    }
#undef SGU_PREFETCH
}
__device__ __forceinline__ void bf8_to_f(const v4u z, f32x4& a, f32x4& b) { a = (f32x4){pg8::bf_lo(z.x), pg8::bf_hi(z.x), pg8::bf_lo(z.y), pg8::bf_hi(z.y)}; b = (f32x4){pg8::bf_lo(z.z), pg8::bf_hi(z.z), pg8::bf_lo(z.w), pg8::bf_hi(z.w)}; }
__device__ __forceinline__ void pool_phase(const bf16* __restrict__ ZB, bf16* __restrict__ PO, int gtid, int gthreads) {
    for (int item = gtid; item < 512 * 256; item += gthreads) {
        const int c8 = item & 255, seg = item >> 8, w = 2 << (c8 >> 6), t0 = seg * 32; const bf16* zp = ZB + c8 * 8;
        f32x4 s0 = (f32x4){0.f, 0.f, 0.f, 0.f}, s1 = s0;
        { v4u z[16];
#pragma unroll
            for (int k = 0; k < 16; ++k) { const int t = t0 - 1 - k; z[k] = (k < w && t >= 0) ? *(const v4u*)(zp + (size_t)t * 2048) : (v4u){0u, 0u, 0u, 0u}; }
#pragma unroll
            for (int k = 0; k < 16; ++k) { f32x4 a, b; bf8_to_f(z[k], a, b); s0 += a; s1 += b; } }
#pragma unroll 1
        for (int blk = 0; blk < 4; ++blk) { v4u zc[8], zo[8];
#pragma unroll
            for (int k = 0; k < 8; ++k) { const int t = t0 + 8 * blk + k; zc[k] = *(const v4u*)(zp + (size_t)t * 2048); zo[k] = (t >= w) ? *(const v4u*)(zp + (size_t)(t - w) * 2048) : (v4u){0u, 0u, 0u, 0u}; }
#pragma unroll
            for (int k = 0; k < 8; ++k) { const int t = t0 + 8 * blk + k; f32x4 c0, c1, o0, o1; bf8_to_f(zc[k], c0, c1); bf8_to_f(zo[k], o0, o1);
                s0 += c0 - o0; s1 += c1 - o1;
                const float inv = 1.0f / (float)(t + 1 < w ? t + 1 : w); const f32x4 p0 = s0 * inv - c0, p1 = s1 * inv - c1;
                v4u o; o.x = pk2(p0.x, p0.y); o.y = pk2(p0.z, p0.w); o.z = pk2(p1.x, p1.y); o.w = pk2(p1.z, p1.w); *(v4u*)(PO + (size_t)t * 2048 + c8 * 8) = o; } }
    }
}

#define XB_TMO      128
#define XB_XCNT(j)  (256  + 64 * (j))
#define XB_XSUB(j)  (1280 + 64 * (j))
#define XB_XGEN(j)  (2304 + 64 * (j))
#define XB_TOP      3328
#define XB_TOPGEN   3392
#define XCD_BAR_WORDS 3456
#define XB_SPIN_CAP (1u << 18)

__device__ __forceinline__ unsigned xb_ld(unsigned* p)              { return __hip_atomic_load(p, __ATOMIC_RELAXED, __HIP_MEMORY_SCOPE_AGENT); }
__device__ __forceinline__ unsigned xb_add(unsigned* p, unsigned v) { return __hip_atomic_fetch_add(p, v, __ATOMIC_RELAXED, __HIP_MEMORY_SCOPE_AGENT); }
__device__ __forceinline__ unsigned xb_xcc_id() { return (unsigned)__builtin_amdgcn_s_getreg((3 << 11) | 20) & 0xFu; }
#define XB_SPIN(cond, bar) do { unsigned _sp = 0; while (cond) { __builtin_amdgcn_s_sleep(1); \
    if ((++_sp & 255u) == 0u) { if (xb_ld(&(bar)[XB_TMO])) break; if (_sp > XB_SPIN_CAP) { atomicAdd(&(bar)[XB_TMO], 1u); break; } } } } while (0)

struct XcdBarrier {
    unsigned* bar; unsigned x;
    volatile LAS unsigned* st;
};

__device__ __forceinline__ XcdBarrier xcd_barrier_post(unsigned* bar, volatile LAS unsigned* st) {
    XcdBarrier b; b.bar = bar; b.x = xb_xcc_id(); b.st = st;
    if (threadIdx.x == 0) (void)xb_add(&bar[XB_XCNT(b.x)], 1u);
    return b;
}
__device__ __forceinline__ void xcd_barrier_complete(unsigned* bar, unsigned x, unsigned& nloc, unsigned& nx) {
    const unsigned G = gridDim.x * gridDim.y * gridDim.z;
    unsigned sum, cnt, mine, sp = 0u;
    for (;;) {
        sum = 0u; cnt = 0u; mine = 0u;
#pragma unroll
        for (unsigned j = 0; j < 16; ++j) { const unsigned c = xb_ld(&bar[XB_XCNT(j)]); sum += c; cnt += (c > 0u) ? 1u : 0u; mine = (j == x) ? c : mine; }
        if (sum == G) break;
        __builtin_amdgcn_s_sleep(1);
        if ((++sp & 255u) == 0u) { if (xb_ld(&bar[XB_TMO])) break; if (sp > XB_SPIN_CAP) { atomicAdd(&bar[XB_TMO], 1u); break; } }
    }
    nloc = mine > 0u ? mine : 1u; nx = cnt > 0u ? cnt : 1u;
}

__device__ __forceinline__ void xcd_barrier(const XcdBarrier& b) {
    asm volatile("s_waitcnt vmcnt(0)" ::: "memory");
    __syncthreads();
    if (threadIdx.x == 0) {
        unsigned* bar = b.bar;
        __builtin_amdgcn_s_waitcnt(0);
        unsigned nloc = b.st[0], nx = b.st[1];
        if (nloc == 0u) { xcd_barrier_complete(bar, b.x, nloc, nx); b.st[0] = nloc; b.st[1] = nx; }
        const unsigned old = xb_add(&bar[XB_XSUB(b.x)], 1u);
        const unsigned gen = old / nloc;
        if (old + 1u == (gen + 1u) * nloc) {
            __builtin_amdgcn_fence(__ATOMIC_RELEASE, "agent");
            asm volatile("s_waitcnt vmcnt(0)" ::: "memory");
            const unsigned og = xb_add(&bar[XB_TOP], 1u);
            const unsigned tg = og / nx;
            if (og + 1u == (tg + 1u) * nx) xb_add(&bar[XB_TOPGEN], 1u);
            else XB_SPIN(xb_ld(&bar[XB_TOPGEN]) == tg, bar);
            __builtin_amdgcn_fence(__ATOMIC_ACQUIRE, "agent");
            xb_add(&bar[XB_XGEN(b.x)], 1u);
            asm volatile("s_waitcnt vmcnt(0)" ::: "memory");
        } else {
            XB_SPIN(xb_ld(&bar[XB_XGEN(b.x)]) == gen, bar);
            __builtin_amdgcn_fence(__ATOMIC_ACQUIRE, "agent");
            asm volatile("s_waitcnt vmcnt(0)" ::: "memory");
        }
    }
    __syncthreads();
}

__device__ __forceinline__ void build_rstd_table(LAS unsigned char* lds, const float* slots, int pm, int t) {
    if (t < 256) { const f32x4* sp = (const f32x4*)(slots + ((size_t)pm * 256 + t) * 32); float q = 0.f;
#pragma unroll
        for (int k = 0; k < 8; ++k) { const f32x4 a = sp[k]; q += (a[0] + a[1]) + (a[2] + a[3]); }
        ((LAS float*)(lds + RSTD_OFF))[t] = 1.0f / sqrtf(q * (1.0f / 2048.0f) + RMS_EPS); }
    __syncthreads();
}
struct Args { const float* in[20]; float* out; unsigned char* ws; int ph_lo, ph_hi; };
__global__ void __launch_bounds__(NWAVES * 64, 2) mk_fwd(Args args) {
    extern __shared__ __attribute__((aligned(16))) unsigned char lds_raw[];
    LAS unsigned char* lds = (LAS unsigned char*)lds_raw;
    const int wave = __builtin_amdgcn_readfirstlane((int)threadIdx.x >> 6);
#define LANE() ((int)__builtin_amdgcn_mbcnt_hi(~0u, __builtin_amdgcn_mbcnt_lo(~0u, 0u)))
    const int G = gridDim.x, bid = blockIdx.x;
    const int gw = bid * NWAVES + wave, NGW = G * NWAVES;
#define PTRS() unsigned char* ws = args.ws; float* out = args.out; asm volatile("" : "+s"(ws), "+s"(out)); \
    bf16* Win_t = (bf16*)(ws + WS_WIN); bf16* Wba_t = (bf16*)(ws + WS_WBA); bf16* Wbb_t = (bf16*)(ws + WS_WBB); bf16* Wout_t = (bf16*)(ws + WS_WOUT); bf16* Wpool_t = (bf16*)(ws + WS_WPOOL); \
    bf16* W1i_t = (bf16*)(ws + WS_W1); bf16* W1o_t = (bf16*)(ws + WS_W1O); bf16* W2i_t = (bf16*)(ws + WS_W2); bf16* W2o_t = (bf16*)(ws + WS_W2O); bf16* XN = (bf16*)(ws + WS_XN); bf16* HID = (bf16*)(ws + WS_BIG); \
    bf16* U = (bf16*)(ws + WS_BIG); bf16* V = (bf16*)(ws + WS_BIG + 64 * MiB); bf16* ZB = (bf16*)(ws + WS_BIG + 128 * MiB); bf16* GA = (bf16*)(ws + WS_BIG + 192 * MiB); bf16* GB = (bf16*)(ws + WS_W1); \
    float* STATS = (float*)(ws + WS_STATS); float* SLOTS = (float*)(ws + WS_SLOTS); const float* x = args.in[0]; \
    (void)Win_t; (void)Wba_t; (void)Wbb_t; (void)Wout_t; (void)Wpool_t; (void)W1i_t; (void)W1o_t; (void)W2i_t; (void)W2o_t; (void)XN; (void)HID; (void)U; (void)V; (void)ZB; (void)GA; (void)GB; (void)STATS; (void)SLOTS; (void)x; (void)out
    const int lo = args.ph_lo, hi = args.ph_hi;
#ifndef PH_MASK
#define PH_MASK 0x7ff
#endif
#define IN(k) (((PH_MASK >> (k)) & 1) && lo <= (k) && (k) < hi)
    XcdBarrier xbar; xbar.bar = (unsigned*)(args.ws + WS_BAR); xbar.x = 0; xbar.st = (volatile LAS unsigned*)(lds + RING_BYTES);
    if (args.ph_hi - args.ph_lo > 1) { if (threadIdx.x < 2) xbar.st[threadIdx.x] = 0u; __syncthreads(); xbar = xcd_barrier_post(xbar.bar, xbar.st); }
    if (args.ph_hi > 1000) cg::this_grid().sync();
#define SEAM(k) do { if (IN(k) && IN((k) + 1)) xcd_barrier(xbar); } while (0)
    if (IN(0)) { PTRS(); const int lane = LANE(); LAS float* scr = (LAS float*)(lds + wave * 16384);
        constexpr int NIT = 2 * (IT_FFN_IN + IT_FFN_OUT) + IT_WIN + 3 * IT_DD + 4 * IT_POOL;
#define P0_ITEM(t, it_) do { int r = (it_); \
            if (r < IT_FFN_IN) { t = t_swiglu(args.in[2], W1i_t, r, nullptr); break; } r -= IT_FFN_IN; \
            if (r < IT_FFN_OUT) { t = t_plain(args.in[3], FF, D, W1o_t, r, nullptr); break; } r -= IT_FFN_OUT; \
            if (r < IT_FFN_IN) { t = t_swiglu(args.in[17], W2i_t, r, args.in[16]); break; } r -= IT_FFN_IN; \
            if (r < IT_FFN_OUT) { t = t_plain(args.in[18], FF, D, W2o_t, r, nullptr); break; } r -= IT_FFN_OUT; \
            if (r < IT_WIN) { t = t_plain(args.in[5], D, NIN, Win_t, r, args.in[4]); break; } r -= IT_WIN; \
            if (r < IT_DD) { t = t_plain(args.in[13], D, D, Wba_t, r, nullptr); break; } r -= IT_DD; \
            if (r < IT_DD) { t = t_plain(args.in[14], D, D, Wbb_t, r, nullptr); break; } r -= IT_DD; \
            if (r < IT_DD) { t = t_plain(args.in[15], D, D, Wout_t, r, nullptr); break; } r -= IT_DD; \
            { const int gp = r / IT_POOL; t = t_plain(args.in[11] + (size_t)gp * 512 * 512, 512, 512, Wpool_t + (size_t)gp * 512 * 512, r % IT_POOL, nullptr); } } while (0)
        if (gw < NIT) { TItem cur, nx; f32x4 rc[8], rn[8]; P0_ITEM(cur, gw); t_load(cur, rc, lane); nx = cur;
            if (gw + NGW < NIT) { P0_ITEM(nx, gw + NGW); t_load(nx, rn, lane); }
            for (int it = gw; it < NIT; it += NGW) { const int nit = it + 2 * NGW; TItem n2 = nx; f32x4 r2[8];
                if (nit < NIT) { P0_ITEM(n2, nit); t_load(n2, r2, lane); }
                t_store(cur, rc, scr, lane); cur = nx; nx = n2;
#pragma unroll
                for (int i = 0; i < 8; ++i) { rc[i] = rn[i]; rn[i] = r2[i]; } } }
#undef P0_ITEM
        rms_rows<false>(x, args.in[1], XN, gw, NGW, lane);
    }
    SEAM(0);
    if (IN(1)) { PTRS(); pg8::Gemm g{XN, W1i_t, M, 2 * FF, D, D, D, 0, 0}; pg8::StaticOrder S; S.init(M, 2 * FF, G, bid); pg8::EpiSwiglu<false> E{HID, FF, nullptr, nullptr, -1};
        pg8::gemm_phase<pg8::EpiSwiglu<false>, pg8::StaticOrder, true, true>(lds, g, S, E, wave); }
    SEAM(1);
    if (IN(2)) { PTRS(); pg8::Gemm g{HID, W1o_t, M, D, FF, FF, FF, 0, 0}; pg8::StaticOrder S; S.init(M, D, G, bid); pg8::EpiResid<true> E{x, out, D, 0.5f, XN, SLOTS};
        pg8::gemm_phase<pg8::EpiResid<true>, pg8::StaticOrder, true, true>(lds, g, S, E, wave); }
    SEAM(2);
    if (IN(3)) { PTRS(); pg8::Gemm g{XN, Win_t, M, NIN, D, D, D, 0, 0}; pg8::StaticOrder S; S.init(M, NIN, G, bid); pg8::Unit u0{0, 0}; S.next(0, u0); build_rstd_table(lds, SLOTS, u0.pm, wave * 64 + LANE());
        pg8::EpiProj E{U, V, ZB, GA, GB, args.in[6], STATS, SLOTS, (const LAS float*)(lds + RSTD_OFF), u0.pm};
        pg8::gemm_phase<pg8::EpiProj, pg8::StaticOrder, true, true>(lds, g, S, E, wave); }
    SEAM(3);
    if (IN(4)) { PTRS();
#ifndef NO_SGU
        sgu_phase(lds, U, V, STATS, args.in[7], args.in[8], args.in[9], args.in[10], G, bid, wave);
#endif
#ifndef NO_POOL
        pool_phase(ZB, XN, (bid * NWAVES + wave) * 64 + LANE(), G * NWAVES * 64);
#endif
    }
    SEAM(4);
    if (IN(5)) { PTRS();
        { pg8::Gemm g{XN, Wpool_t, M, D, 512, D, 512, 1, 512}; pg8::StaticOrder S; S.init(M, D, G, bid); pg8::EpiScale E{V, args.in[12]};
          pg8::gemm_phase<pg8::EpiScale, pg8::StaticOrder, true, true>(lds, g, S, E, wave); }
        { pg8::Gemm g{U, Wba_t, M, D, D, D, D, 0, 0}; pg8::StaticOrder S; S.init(M, D, G, bid); pg8::EpiGate<false> E{GA, GA, GA};
          pg8::gemm_phase<pg8::EpiGate<false>, pg8::StaticOrder, true, true>(lds, g, S, E, wave); }
    }
    SEAM(5);
    if (IN(6)) { PTRS(); pg8::Gemm g{V, Wbb_t, M, D, D, D, D, 0, 0}; pg8::StaticOrder S; S.init(M, D, G, bid); pg8::EpiGate<true> E{GB, GA, GB};
        pg8::gemm_phase<pg8::EpiGate<true>, pg8::StaticOrder, true, true>(lds, g, S, E, wave); }
    SEAM(6);
    if (IN(7)) { PTRS(); pg8::Gemm g{GB, Wout_t, M, D, D, D, D, 0, 0}; pg8::StaticOrder S; S.init(M, D, G, bid); pg8::EpiResid<true> E{out, out, D, 1.0f, XN, SLOTS};
        pg8::gemm_phase<pg8::EpiResid<true>, pg8::StaticOrder, true, true>(lds, g, S, E, wave); }
    SEAM(7);
    if (IN(8)) { PTRS(); pg8::Gemm g{XN, W2i_t, M, 2 * FF, D, D, D, 0, 0}; pg8::StaticOrder S; S.init(M, 2 * FF, G, bid); pg8::Unit u0{0, 0}; S.next(0, u0); build_rstd_table(lds, SLOTS, u0.pm, wave * 64 + LANE());
        pg8::EpiSwiglu<true> E{HID, FF, SLOTS, (const LAS float*)(lds + RSTD_OFF), u0.pm};
        pg8::gemm_phase<pg8::EpiSwiglu<true>, pg8::StaticOrder, true, true>(lds, g, S, E, wave); }
    SEAM(8);
    if (IN(9)) { PTRS(); pg8::Gemm g{HID, W2o_t, M, D, FF, FF, FF, 0, 0}; pg8::StaticOrder S; S.init(M, D, G, bid); pg8::EpiResid<false> E{out, out, D, 0.5f, nullptr, nullptr};
        pg8::gemm_phase<pg8::EpiResid<false>, pg8::StaticOrder, true, true>(lds, g, S, E, wave); }
    SEAM(9);
    if (IN(10)) { PTRS(); const int lane = LANE(); rms_rows<true>(out, args.in[19], out, gw, NGW, lane); }
#undef IN
#undef SEAM
}

extern "C" void kernel_launch(void* const* d_in, const int* in_sizes, int n_in, void* d_out, int out_size, void* d_ws, size_t ws_size, hipStream_t stream) {
    static int grid = 0;
    if (grid == 0) {
        if (n_in != 20 || in_sizes[0] != M * D || out_size != M * D || ws_size < WS_END) { fprintf(stderr, "kernel_launch: unexpected shapes (n_in %d, in0 %d, out %d, ws %zu, need %zu); nothing launched\n", n_in, n_in > 0 ? in_sizes[0] : -1, out_size, ws_size, (size_t)WS_END); grid = -1; return; }
        int dev = 0, cus = 0, per_cu = 0;
        (void)hipGetDevice(&dev); (void)hipDeviceGetAttribute(&cus, hipDeviceAttributeMultiprocessorCount, dev);
        if (hipFuncSetAttribute((const void*)mk_fwd, hipFuncAttributeMaxDynamicSharedMemorySize, LDS_BYTES) != hipSuccess) { fprintf(stderr, "kernel_launch: hipFuncSetAttribute failed\n"); grid = -1; return; }
        if (hipOccupancyMaxActiveBlocksPerMultiprocessor(&per_cu, (const void*)mk_fwd, NWAVES * 64, LDS_BYTES) != hipSuccess || per_cu < 1) { fprintf(stderr, "kernel_launch: occupancy query says %d\n", per_cu); per_cu = 1; }
        (void)hipGetLastError();
        grid = cus * per_cu;
        if (grid % 8 != 0 || grid <= 0) { fprintf(stderr, "kernel_launch: grid %d not a multiple of 8\n", grid); grid = -1; return; }
    }
    if (grid < 0) return;
    if (hipMemsetAsync((char*)d_ws + WS_BAR, 0, BAR_BYTES, stream) != hipSuccess) { fprintf(stderr, "kernel_launch: memset of the barrier words failed\n"); return; }
    Args a{};
    for (int i = 0; i < 20; ++i) a.in[i] = (const float*)d_in[i];
    a.out = (float*)d_out; a.ws = (unsigned char*)d_ws;
#if MK_PER_PHASE
    for (int p = 0; p < N_PHASES; ++p) { a.ph_lo = p; a.ph_hi = p + 1; hipLaunchKernelGGL(mk_fwd, dim3(grid), dim3(NWAVES * 64), LDS_BYTES, stream, a); }
#else
    a.ph_lo = 0; a.ph_hi = N_PHASES;
    void* kargs[] = {&a};
    hipError_t e = hipLaunchCooperativeKernel((const void*)mk_fwd, dim3(grid), dim3(NWAVES * 64), kargs, LDS_BYTES, stream);
    if (e != hipSuccess) fprintf(stderr, "kernel_launch: cooperative launch failed: %s (grid %d)\n", hipGetErrorString(e), grid);
#endif
}
```

```cpp
#include <hip/hip_runtime.h>
#include <hip/hip_cooperative_groups.h>
#include <cstdio>
#include <cstdint>
namespace cg = cooperative_groups;
namespace pg8 {
#define PG8_LAS __attribute__((address_space(3)))
typedef unsigned short bf16_t;
typedef short bf16x8 __attribute__((ext_vector_type(8)));
typedef float f32x4 __attribute__((ext_vector_type(4)));
typedef unsigned u32x4 __attribute__((ext_vector_type(4)));
constexpr int BM = 256, BK = 64, HALF = 128, HTB = HALF * BK * 2  , STAGE_BYTES = 8 * HTB, NXCD = 8, WGM = 8;

__host__ __device__ __forceinline__ int lds_byte(int r, int c) { const int st = (r >> 4) * 2 + (c >> 5), rr = r & 15, cc = c & 31, ob = rr * 64 + cc * 2; return st * 1024 + (ob ^ (((ob >> 9) & 1) << 5)); }
__host__ __device__ __forceinline__ void stage_rc(int b, int& R, int& C) { const int st = b / 1024, sb = b % 1024, swz = sb ^ (((sb >> 9) & 1) << 5); R = (st >> 1) * 16 + swz / 64; C = (st & 1) * 32 + (swz % 64) / 2; }
__host__ __device__ __forceinline__ int perm32(int rho) { const int n = rho >> 4, i = rho & 15; return 8 * (i >> 2) + 4 * n + (i & 3); }

struct Unit { int pm, pn; };
struct Gemm { const bf16_t* A; const bf16_t* Bt; int M, N, K, lda, ldb, gshift, gk; };

struct StaticOrder {
    int nM, nN, nwg, G, c;
    __host__ __device__ void init(int M, int N, int G_, int c_) { nM = M / BM; nN = N / BM; nwg = nM * nN; G = G_; c = c_; }
    __host__ __device__ bool next(int i, Unit& u) const {
        const long L = (long)i * G + c; if (L >= nwg) return false;
        int wgid = (int)L; { const int q = nwg / NXCD, r = nwg % NXCD, xcd = wgid % NXCD, off = wgid / NXCD; wgid = (xcd < r ? xcd * (q + 1) : r * (q + 1) + (xcd - r) * q) + off; }
        const int nig = WGM * nN, gid = wgid / nig, fm = gid * WGM, gsz = (nM - fm) < WGM ? (nM - fm) : WGM;
        u.pm = fm + ((wgid % nig) % gsz); u.pn = (wgid % nig) / gsz; return true;
    }
    __device__ __forceinline__ void a_ready(const Unit&) const {}
    __device__ __forceinline__ void done(const Unit&) const {}
};

__device__ __forceinline__ unsigned cvt_pk_bf16(float lo, float hi) { unsigned r; asm volatile("v_cvt_pk_bf16_f32 %0, %1, %2" : "=v"(r) : "v"(lo), "v"(hi)); return r; }
typedef float f32x2 __attribute__((ext_vector_type(2)));
__device__ __forceinline__ f32x2 gelu_pk(f32x2 v) {
    const f32x2 av = __builtin_elementwise_abs(v), d = av * 0.2316418882f + 1.0f;
    f32x2 t; t.x = __builtin_amdgcn_rcpf(d.x); t.y = __builtin_amdgcn_rcpf(d.y);
    f32x2 q = t * 0.5307027145f + (-0.7265760135f); q = q * t + 0.7107068705f; q = q * t + (-0.142248368f); q = q * t + 0.127414796f; q = q * t;
    const f32x2 s = (v * v) * (-0.72134752044f);
    f32x2 e; e.x = __builtin_amdgcn_exp2f(s.x); e.y = __builtin_amdgcn_exp2f(s.y);
    const f32x2 m = v * (q * e), r = v - m;
    f32x2 o; o.x = v.x < 0.f ? m.x : r.x; o.y = v.y < 0.f ? m.y : r.y; return o;
}

__device__ __forceinline__ float bf_lo(unsigned w) { return __uint_as_float(w << 16); }
__device__ __forceinline__ float bf_hi(unsigned w) { return __uint_as_float(w & 0xffff0000u); }
__device__ __forceinline__ float fast_sigmoid(float x) { return __builtin_amdgcn_rcpf(1.0f + __builtin_amdgcn_exp2f(x * -1.44269504089f)); }

__device__ __forceinline__ float row_rstd(const float* slots, int row, int fq) {
    const f32x4* sp = (const f32x4*)(slots + (size_t)row * 32 + fq * 8); const f32x4 a = sp[0], b = sp[1]; float q = ((a[0] + a[1]) + (a[2] + a[3])) + ((b[0] + b[1]) + (b[2] + b[3]));
    q += __shfl_xor(q, 16); q += __shfl_xor(q, 32); return 1.0f / sqrtf(q * (1.0f / 2048.0f) + 1e-6f);
}
__device__ __forceinline__ void row_rstd4(const float* slots, int row0, int fq, float (&rs)[4]) {
    f32x4 a[4], b[4];
#pragma unroll
    for (int m = 0; m < 4; ++m) { const f32x4* sp = (const f32x4*)(slots + (size_t)(row0 + 16 * m) * 32 + fq * 8); a[m] = sp[0]; b[m] = sp[1]; }
#pragma unroll
    for (int m = 0; m < 4; ++m) { float q = ((a[m][0] + a[m][1]) + (a[m][2] + a[m][3])) + ((b[m][0] + b[m][1]) + (b[m][2] + b[m][3]));
        q += __shfl_xor(q, 16); q += __shfl_xor(q, 32); rs[m] = 1.0f / sqrtf(q * (1.0f / 2048.0f) + 1e-6f); }
}
template <bool RS> struct EpiSwiglu {
    static constexpr bool PERM = true, AFTER_DRAIN = false;
    bf16_t* O; int ldc; const float* slots; const PG8_LAS float* rtab; int pm0;
    __device__ __forceinline__ void operator()(const f32x4 (&acc)[2][2][4][2], const Unit& u, int wr, int wc, int fr, int fq) const {
        const int row0 = u.pm * BM + wr * 64 + fr, col0 = u.pn * HALF + wc * 32 + 8 * fq;
#pragma unroll
        for (int ai = 0; ai < 2; ++ai) { float rs4[4] = {1.f, 1.f, 1.f, 1.f};
            if (RS) { if (u.pm == pm0) {
#pragma unroll
                for (int m = 0; m < 4; ++m) rs4[m] = rtab[wr * 64 + fr + ai * HALF + m * 16]; } else row_rstd4(slots, row0 + ai * HALF, fq, rs4); }
#pragma unroll
            for (int m = 0; m < 4; ++m) { bf16_t* rowp = O + (size_t)(row0 + ai * HALF + m * 16) * ldc + col0;
                f32x4 g0 = acc[ai][0][m][0], g1 = acc[ai][0][m][1], u0 = acc[ai][1][m][0], u1 = acc[ai][1][m][1];
                if (RS) { const float rs = rs4[m]; g0 = g0 * rs; g1 = g1 * rs; u0 = u0 * rs; u1 = u1 * rs; }
#pragma unroll
                for (int j = 0; j < 4; ++j) { g0[j] = g0[j] * fast_sigmoid(g0[j]) * u0[j]; g1[j] = g1[j] * fast_sigmoid(g1[j]) * u1[j]; }
                u32x4 w; w.x = cvt_pk_bf16(g0[0], g0[1]); w.y = cvt_pk_bf16(g0[2], g0[3]); w.z = cvt_pk_bf16(g1[0], g1[1]); w.w = cvt_pk_bf16(g1[2], g1[3]);
                *(u32x4*)rowp = w; } }
    }
};
template <bool NORM> struct EpiResid {
    static constexpr bool PERM = false, AFTER_DRAIN = false;
    const float* res; float* out; int ldc; float alpha; bf16_t* xn; float* slots;
    __device__ __forceinline__ void operator()(const f32x4 (&acc)[2][2][4][2], const Unit& u, int wr, int wc, int fr, int fq) const {
        const int row0 = u.pm * BM + wr * 64 + fr, col0 = u.pn * BM + wc * 32 + 4 * fq;
#pragma unroll
        for (int ai = 0; ai < 2; ++ai)
#pragma unroll
            for (int mp = 0; mp < 1; ++mp) { f32x4 r[4][2][2];
#pragma unroll
                for (int mm = 0; mm < 4; ++mm)
#pragma unroll
                    for (int bj = 0; bj < 2; ++bj)
#pragma unroll
                        for (int n = 0; n < 2; ++n) r[mm][bj][n] = *(const f32x4*)(res + (size_t)(row0 + ai * HALF + mm * 16) * ldc + col0 + bj * HALF + n * 16);
#pragma unroll
                for (int mm = 0; mm < 4; ++mm) { const int m = mm, row = row0 + ai * HALF + m * 16; const size_t off = (size_t)row * ldc + col0; float q = 0.f;
#pragma unroll
                    for (int bj = 0; bj < 2; ++bj)
#pragma unroll
                        for (int n = 0; n < 2; ++n) { const f32x4 o = r[mm][bj][n] + acc[ai][bj][m][n] * alpha; *(f32x4*)(out + off + bj * HALF + n * 16) = o;
                            if (NORM) { q += (o[0] * o[0] + o[1] * o[1]) + (o[2] * o[2] + o[3] * o[3]); typedef unsigned u32x2 __attribute__((ext_vector_type(2)));
                                u32x2 w; w.x = cvt_pk_bf16(o[0], o[1]); w.y = cvt_pk_bf16(o[2], o[3]); *(u32x2*)(xn + off + bj * HALF + n * 16) = w; } }
                    if (NORM) { q += __shfl_xor(q, 16); q += __shfl_xor(q, 32); if (fq == 0) slots[(size_t)row * 32 + u.pn * 4 + wc] = q; } }
                asm volatile("" ::: "memory"); }
    }
};
template <bool RES_BF16> struct EpiResidB {
    static constexpr bool PERM = true, AFTER_DRAIN = false;
    const float* res; bf16_t* xn; float* slots; float alpha;
    __device__ __forceinline__ void operator()(const f32x4 (&acc)[2][2][4][2], const Unit& u, int wr, int wc, int fr, int fq) const {
        const int row0 = u.pm * BM + wr * 64 + fr, col0 = u.pn * BM + wc * 32 + 8 * fq;
#pragma unroll
        for (int ai = 0; ai < 2; ++ai) { u32x4 rb[4][2]; f32x4 rf[4][2][2];
#pragma unroll
            for (int m = 0; m < 4; ++m)
#pragma unroll
                for (int bj = 0; bj < 2; ++bj) { const size_t off = (size_t)(row0 + ai * HALF + m * 16) * 2048 + col0 + bj * HALF;
                    if (RES_BF16) rb[m][bj] = *(const u32x4*)(xn + off); else { rf[m][bj][0] = *(const f32x4*)(res + off); rf[m][bj][1] = *(const f32x4*)(res + off + 4); } }
#pragma unroll
            for (int m = 0; m < 4; ++m) { const int row = row0 + ai * HALF + m * 16; float q = 0.f;
#pragma unroll
                for (int bj = 0; bj < 2; ++bj) { const size_t off = (size_t)row * 2048 + col0 + bj * HALF; f32x4 r0, r1;
                    if (RES_BF16) { const u32x4 b = rb[m][bj]; r0 = (f32x4){bf_lo(b.x), bf_hi(b.x), bf_lo(b.y), bf_hi(b.y)}; r1 = (f32x4){bf_lo(b.z), bf_hi(b.z), bf_lo(b.w), bf_hi(b.w)}; } else { r0 = rf[m][bj][0]; r1 = rf[m][bj][1]; }
                    const f32x4 o0 = r0 + acc[ai][bj][m][0] * alpha, o1 = r1 + acc[ai][bj][m][1] * alpha;
                    q += ((o0[0] * o0[0] + o0[1] * o0[1]) + (o0[2] * o0[2] + o0[3] * o0[3])) + ((o1[0] * o1[0] + o1[1] * o1[1]) + (o1[2] * o1[2] + o1[3] * o1[3]));
                    u32x4 w; w.x = cvt_pk_bf16(o0[0], o0[1]); w.y = cvt_pk_bf16(o0[2], o0[3]); w.z = cvt_pk_bf16(o1[0], o1[1]); w.w = cvt_pk_bf16(o1[2], o1[3]);
                    *(u32x4*)(xn + off) = w; }
                q += __shfl_xor(q, 16); q += __shfl_xor(q, 32); if (fq == 0) slots[(size_t)row * 32 + u.pn * 4 + wc] = q; }
            asm volatile("" ::: "memory"); }
    }
};
struct EpiProj {
    static constexpr bool PERM = true, AFTER_DRAIN = false;
    bf16_t *U, *V, *ZB, *GA, *GB; const float* bias; float* stats; const float* slots; const PG8_LAS float* rtab; int pm0;
    __device__ __forceinline__ void operator()(const f32x4 (&acc)[2][2][4][2], const Unit& u, int wr, int wc, int fr, int fq) const {
        const int grp = u.pn >> 3, row0 = u.pm * BM + wr * 64 + fr, col0 = (u.pn & 7) * BM + wc * 32 + 8 * fq, bcol0 = u.pn * BM + wc * 32 + 8 * fq;
        bf16_t* base = grp == 0 ? U : grp == 1 ? V : grp == 2 ? ZB : grp == 3 ? GA : GB;
        f32x4 bv[2][2];
#pragma unroll
        for (int bj = 0; bj < 2; ++bj)
#pragma unroll
            for (int n = 0; n < 2; ++n) bv[bj][n] = *(const f32x4*)(bias + bcol0 + bj * HALF + 4 * n);
#pragma unroll
        for (int ai = 0; ai < 2; ++ai) { float rs4[4];
            if (u.pm == pm0) {
#pragma unroll
                for (int m = 0; m < 4; ++m) rs4[m] = rtab[wr * 64 + fr + ai * HALF + m * 16]; } else row_rstd4(slots, row0 + ai * HALF, fq, rs4);
#pragma unroll
            for (int m = 0; m < 4; ++m) { const int row = row0 + ai * HALF + m * 16; bf16_t* rowp = base + (size_t)row * 2048 + col0; float s = 0.f, q = 0.f; const float rs = rs4[m];
#pragma unroll
                for (int bj = 0; bj < 2; ++bj) { f32x4 v0 = acc[ai][bj][m][0] * rs + bv[bj][0], v1 = acc[ai][bj][m][1] * rs + bv[bj][1];
                    if (grp < 2) { f32x2 a = gelu_pk((f32x2){v0[0], v0[1]}), b = gelu_pk((f32x2){v0[2], v0[3]}), c = gelu_pk((f32x2){v1[0], v1[1]}), d = gelu_pk((f32x2){v1[2], v1[3]});
                        v0 = (f32x4){a.x, a.y, b.x, b.y}; v1 = (f32x4){c.x, c.y, d.x, d.y};
                        s += ((v0[0] + v0[1]) + (v0[2] + v0[3])) + ((v1[0] + v1[1]) + (v1[2] + v1[3]));
                        q += ((v0[0] * v0[0] + v0[1] * v0[1]) + (v0[2] * v0[2] + v0[3] * v0[3])) + ((v1[0] * v1[0] + v1[1] * v1[1]) + (v1[2] * v1[2] + v1[3] * v1[3])); }
                    else if (grp >= 3) {
#pragma unroll
                        for (int j = 0; j < 4; ++j) { v0[j] = fast_sigmoid(v0[j]); v1[j] = fast_sigmoid(v1[j]); } }
                    u32x4 w; w.x = cvt_pk_bf16(v0[0], v0[1]); w.y = cvt_pk_bf16(v0[2], v0[3]); w.z = cvt_pk_bf16(v1[0], v1[1]); w.w = cvt_pk_bf16(v1[2], v1[3]);
                    *(u32x4*)(rowp + bj * HALF) = w; }
                if (grp == 1) { s += __shfl_xor(s, 16); s += __shfl_xor(s, 32); q += __shfl_xor(q, 16); q += __shfl_xor(q, 32);
                    if (fq == 0) *(f32x2*)(stats + ((size_t)row * 32 + (u.pn & 7) * 4 + wc) * 2) = (f32x2){s, q}; } } }
    }
};
struct EpiScale {
    static constexpr bool PERM = true, AFTER_DRAIN = false;
    bf16_t* O; const float* scale;
    __device__ __forceinline__ void operator()(const f32x4 (&acc)[2][2][4][2], const Unit& u, int wr, int wc, int fr, int fq) const {
        const int row0 = u.pm * BM + wr * 64 + fr, col0 = u.pn * BM + wc * 32 + 8 * fq;
        f32x4 sv[2][2];
#pragma unroll
        for (int bj = 0; bj < 2; ++bj)
#pragma unroll
            for (int n = 0; n < 2; ++n) sv[bj][n] = *(const f32x4*)(scale + col0 + bj * HALF + 4 * n);
#pragma unroll
        for (int ai = 0; ai < 2; ++ai)
#pragma unroll
            for (int m = 0; m < 4; ++m) { bf16_t* rowp = O + (size_t)(row0 + ai * HALF + m * 16) * 2048 + col0;
#pragma unroll
                for (int bj = 0; bj < 2; ++bj) { const f32x4 v0 = acc[ai][bj][m][0] * sv[bj][0], v1 = acc[ai][bj][m][1] * sv[bj][1];
                    u32x4 w; w.x = cvt_pk_bf16(v0[0], v0[1]); w.y = cvt_pk_bf16(v0[2], v0[3]); w.z = cvt_pk_bf16(v1[0], v1[1]); w.w = cvt_pk_bf16(v1[2], v1[3]);
                    *(u32x4*)(rowp + bj * HALF) = w; } }
    }
};
template <bool ADD> struct EpiGate {
    static constexpr bool PERM = true, AFTER_DRAIN = false;
    const bf16_t* G; const bf16_t* P; bf16_t* O;
    __device__ __forceinline__ void operator()(const f32x4 (&acc)[2][2][4][2], const Unit& u, int wr, int wc, int fr, int fq) const {
        const int row0 = u.pm * BM + wr * 64 + fr, col0 = u.pn * BM + wc * 32 + 8 * fq;
#pragma unroll
        for (int ai = 0; ai < 2; ++ai)
#pragma unroll
            for (int mp = 0; mp < 1; ++mp) { u32x4 gw[4][2], pw[4][2];
#pragma unroll
                for (int mm = 0; mm < 4; ++mm)
#pragma unroll
                    for (int bj = 0; bj < 2; ++bj) { const size_t off = (size_t)(row0 + ai * HALF + mm * 16) * 2048 + col0 + bj * HALF; gw[mm][bj] = *(const u32x4*)(G + off); if (ADD) pw[mm][bj] = *(const u32x4*)(P + off); }
#pragma unroll
                for (int mm = 0; mm < 4; ++mm)
#pragma unroll
                    for (int bj = 0; bj < 2; ++bj) { const int m = mm; const size_t off = (size_t)(row0 + ai * HALF + m * 16) * 2048 + col0 + bj * HALF; const u32x4 g4 = gw[mm][bj]; f32x4 v0 = acc[ai][bj][m][0], v1 = acc[ai][bj][m][1];
                        v0 = v0 * (f32x4){bf_lo(g4.x), bf_hi(g4.x), bf_lo(g4.y), bf_hi(g4.y)}; v1 = v1 * (f32x4){bf_lo(g4.z), bf_hi(g4.z), bf_lo(g4.w), bf_hi(g4.w)};
                        if (ADD) { const u32x4 p4 = pw[mm][bj];
                            v0 = v0 + (f32x4){bf_lo(p4.x), bf_hi(p4.x), bf_lo(p4.y), bf_hi(p4.y)}; v1 = v1 + (f32x4){bf_lo(p4.z), bf_hi(p4.z), bf_lo(p4.w), bf_hi(p4.w)}; }
                        u32x4 w; w.x = cvt_pk_bf16(v0[0], v0[1]); w.y = cvt_pk_bf16(v0[2], v0[3]); w.z = cvt_pk_bf16(v1[0], v1[1]); w.w = cvt_pk_bf16(v1[2], v1[3]);
                        *(u32x4*)(O + off) = w; }
                asm volatile("" ::: "memory"); }
    }
};

template <class Epi, class Sched, bool ALIGN_EPI = false, bool SP2 = false>
__device__ __forceinline__ void gemm_phase(PG8_LAS unsigned char* lds, const Gemm g, const Sched& S, const Epi& E, const int wid) {
    int lane0 = (int)__builtin_amdgcn_mbcnt_hi(~0u, __builtin_amdgcn_mbcnt_lo(~0u, 0u)); asm volatile("" : "+v"(lane0));
    const int lane = lane0, tid = wid * 64 + lane, wr = wid >> 2, wc = wid & 3, fr = lane & 15, fq = lane >> 4;
    const int K = g.K, nt = K / BK;
    unsigned voffA[2], voffB[2];
#pragma unroll
    for (int i = 0; i < 2; ++i) { int R, C; stage_rc(tid * 16 + i * 8192, R, C); const int Rb = Epi::PERM ? ((R & ~31) + perm32(R & 31)) : R;
        voffA[i] = (unsigned)(R * g.lda + C) * 2u; voffB[i] = (unsigned)(Rb * g.ldb + C) * 2u; }
    const size_t kstep = (size_t)(BK * 2);
    const size_t hstepA = (size_t)HALF * g.lda * 2, hstepB = (size_t)HALF * g.ldb * 2;
    const size_t tstepA = 2 * hstepA, tstepB = 2 * hstepB;
    const unsigned ldsw = (unsigned)wid * 1024u;
    const int aoff = lds_byte(wr * 64 + fr, fq * 8), boff = lds_byte(wc * 32 + fr, fq * 8);
#define PG8_SA(b, h) (((b) * 2 + (h)) * HTB)
#define PG8_SB(b, h) ((4 + (b) * 2 + (h)) * HTB)
#define PG8_STAGE(bufoff, gbase, voff) do { _Pragma("unroll") for (int _i = 0; _i < 2; ++_i) \
        __builtin_amdgcn_global_load_lds((const unsigned*)((const char*)(gbase) + (voff)[_i]), (PG8_LAS unsigned*)(lds + (bufoff) + ldsw + _i * 8192), 16, 0, 0); } while (0)
#define PG8_LDA(dst, b, h) do { _Pragma("unroll") for (int m = 0; m < 4; ++m) _Pragma("unroll") for (int k = 0; k < 2; ++k) dst[m][k] = *(const PG8_LAS bf16x8*)(lds + PG8_SA(b, h) + aoff + m * 2048 + k * 1024); } while (0)
#define PG8_LDB(dst, b, h) do { _Pragma("unroll") for (int n = 0; n < 2; ++n) _Pragma("unroll") for (int k = 0; k < 2; ++k) dst[n][k] = *(const PG8_LAS bf16x8*)(lds + PG8_SB(b, h) + boff + n * 2048 + k * 1024); } while (0)
#define PG8_MMA(ai, bj, At, Bt) do { __builtin_amdgcn_s_setprio(1); _Pragma("unroll") for (int k = 0; k < 2; ++k) _Pragma("unroll") for (int m = 0; m < 4; ++m) _Pragma("unroll") for (int nn = 0; nn < 2; ++nn) { const int n = (m & 1) ? 1 - nn : nn;     \
        acc[ai][bj][m][n] = __builtin_amdgcn_mfma_f32_16x16x32_bf16(Bt[n][k], At[m][k], acc[ai][bj][m][n], 0, 0, 0); } __builtin_amdgcn_s_setprio(0); } while (0)
#define PG8_WAIT_V(n) asm volatile("s_waitcnt vmcnt(" #n ")" ::: "memory")
#define PG8_WAIT_L(n) asm volatile("s_waitcnt lgkmcnt(" #n ")" ::: "memory")
#define PG8_BAR __builtin_amdgcn_s_barrier()
#define PG8_SCHED __builtin_amdgcn_sched_barrier(0)
    Unit cur, nxt; int ui = 0;
    if (!S.next(0, cur)) return;
    f32x4 acc[2][2][4][2];
#pragma unroll
    for (int a = 0; a < 2; ++a)
#pragma unroll
        for (int b = 0; b < 2; ++b)
#pragma unroll
            for (int m = 0; m < 4; ++m)
#pragma unroll
                for (int n = 0; n < 2; ++n) acc[a][b][m][n] = (f32x4){0.f, 0.f, 0.f, 0.f};
    bf16x8 At[4][2], B0[2][2], B1[2][2];
    const char* cA = (const char*)g.A + (size_t)cur.pm * tstepA + (size_t)((cur.pn >> g.gshift) * g.gk) * 2; const char* cB = (const char*)g.Bt + (size_t)cur.pn * tstepB;
    S.a_ready(cur);
    if constexpr (SP2) {
        PG8_STAGE(PG8_SB(0, 0), cB, voffB); PG8_STAGE(PG8_SB(0, 1), cB + hstepB, voffB); PG8_STAGE(PG8_SA(0, 0), cA, voffA); PG8_STAGE(PG8_SA(0, 1), cA + hstepA, voffA);
        if (wr == 1) PG8_BAR;
        PG8_WAIT_V(2); PG8_BAR;
        PG8_STAGE(PG8_SB(1, 0), cB + kstep, voffB); PG8_STAGE(PG8_SA(1, 0), cA + kstep, voffA); PG8_STAGE(PG8_SB(1, 1), cB + hstepB + kstep, voffB);
        PG8_WAIT_V(6); PG8_BAR;
    } else {
        PG8_STAGE(PG8_SB(0, 0), cB, voffB); PG8_STAGE(PG8_SA(0, 0), cA, voffA); PG8_STAGE(PG8_SB(0, 1), cB + hstepB, voffB); PG8_STAGE(PG8_SA(0, 1), cA + hstepA, voffA);
        if (wr == 1) PG8_BAR;
        PG8_WAIT_V(4); PG8_BAR;
        PG8_STAGE(PG8_SB(1, 0), cB + kstep, voffB); PG8_STAGE(PG8_SA(1, 0), cA + kstep, voffA); PG8_STAGE(PG8_SB(1, 1), cB + hstepB + kstep, voffB);
        PG8_WAIT_V(6); PG8_BAR;
    }
    for (;;) {
        const bool has_next = S.next(ui + 1, nxt);
        const char* nA = has_next ? (const char*)g.A + (size_t)nxt.pm * tstepA + (size_t)((nxt.pn >> g.gshift) * g.gk) * 2 : cA; const char* nB = has_next ? (const char*)g.Bt + (size_t)nxt.pn * tstepB : cB;
        for (int t = 0; t < nt; t += 2) {
            const bool last = (t == nt - 2);
            const char* a1 = cA + (size_t)(t + 1) * kstep;
            const char* a2 = last ? nA : cA + (size_t)(t + 2) * kstep; const char* b2 = last ? nB : cB + (size_t)(t + 2) * kstep;
            const char* a3 = a2 + kstep; const char* b3 = b2 + kstep;
            if (last && has_next) S.a_ready(nxt);
            if constexpr (SP2) {
            PG8_LDB(B0, 0, 0); PG8_LDB(B1, 0, 1); PG8_SCHED; PG8_LDA(At, 0, 0); PG8_STAGE(PG8_SA(1, 1), a1 + hstepA, voffA);
            PG8_WAIT_V(8); PG8_WAIT_L(0); PG8_BAR; PG8_MMA(0, 0, At, B0); PG8_MMA(0, 1, At, B1); PG8_BAR; PG8_SCHED;
            PG8_LDA(At, 0, 1); PG8_STAGE(PG8_SB(0, 0), b2, voffB); PG8_STAGE(PG8_SB(0, 1), b2 + hstepB, voffB); PG8_STAGE(PG8_SA(0, 0), a2, voffA);
            PG8_WAIT_V(8); PG8_WAIT_L(0); PG8_BAR; PG8_MMA(1, 0, At, B0); PG8_MMA(1, 1, At, B1); PG8_BAR; PG8_SCHED;
            PG8_LDB(B0, 1, 0); PG8_LDB(B1, 1, 1); PG8_SCHED; PG8_LDA(At, 1, 0); PG8_STAGE(PG8_SA(0, 1), a2 + hstepA, voffA);
            PG8_WAIT_V(8); PG8_WAIT_L(0); PG8_BAR; PG8_MMA(0, 0, At, B0); PG8_MMA(0, 1, At, B1); PG8_BAR; PG8_SCHED;
            PG8_LDA(At, 1, 1); PG8_STAGE(PG8_SB(1, 0), b3, voffB); PG8_STAGE(PG8_SB(1, 1), b3 + hstepB, voffB); PG8_STAGE(PG8_SA(1, 0), a3, voffA);
            PG8_WAIT_V(8); PG8_WAIT_L(0); PG8_BAR; PG8_MMA(1, 0, At, B0); PG8_MMA(1, 1, At, B1); PG8_BAR; PG8_SCHED;
            } else {
            PG8_LDB(B0, 0, 0); PG8_SCHED; PG8_LDA(At, 0, 0); PG8_STAGE(PG8_SA(1, 1), a1 + hstepA, voffA);
            PG8_WAIT_L(8); PG8_BAR; PG8_WAIT_L(0); PG8_MMA(0, 0, At, B0); PG8_BAR; PG8_SCHED;
            PG8_LDB(B1, 0, 1); PG8_STAGE(PG8_SB(0, 0), b2, voffB);
            PG8_BAR; PG8_WAIT_L(0); PG8_MMA(0, 1, At, B1); PG8_BAR;
            PG8_LDA(At, 0, 1); PG8_STAGE(PG8_SA(0, 0), a2, voffA);
            PG8_BAR; PG8_WAIT_L(0); PG8_MMA(1, 0, At, B0); PG8_BAR; PG8_SCHED;
            PG8_STAGE(PG8_SB(0, 1), b2 + hstepB, voffB);
            PG8_WAIT_V(6); PG8_BAR; PG8_MMA(1, 1, At, B1); PG8_BAR;
            PG8_LDB(B0, 1, 0); PG8_SCHED; PG8_LDA(At, 1, 0); PG8_STAGE(PG8_SA(0, 1), a2 + hstepA, voffA);
            PG8_WAIT_L(8); PG8_BAR; PG8_WAIT_L(0); PG8_MMA(0, 0, At, B0); PG8_BAR; PG8_SCHED;
            PG8_LDB(B1, 1, 1); PG8_STAGE(PG8_SB(1, 0), b3, voffB);
            PG8_BAR; PG8_WAIT_L(0); PG8_MMA(0, 1, At, B1); PG8_BAR;
            PG8_LDA(At, 1, 1); PG8_STAGE(PG8_SA(1, 0), a3, voffA);
            PG8_BAR; PG8_WAIT_L(0); PG8_MMA(1, 0, At, B0); PG8_BAR; PG8_SCHED;
            PG8_STAGE(PG8_SB(1, 1), b3 + hstepB, voffB);
            PG8_WAIT_V(6); PG8_BAR; PG8_MMA(1, 1, At, B1); PG8_BAR;
            }
        }
        if constexpr (ALIGN_EPI) { if (wr == 0) PG8_BAR; }
        if constexpr (!Epi::AFTER_DRAIN) { E(acc, cur, wr, wc, fr, fq); S.done(cur); }
        if (!has_next) break;
#pragma unroll
        for (int a = 0; a < 2; ++a)
#pragma unroll
            for (int b = 0; b < 2; ++b)
#pragma unroll
                for (int m = 0; m < 4; ++m)
#pragma unroll
                    for (int n = 0; n < 2; ++n) acc[a][b][m][n] = (f32x4){0.f, 0.f, 0.f, 0.f};
        cur = nxt; cA = nA; cB = nB; ++ui;
        if constexpr (ALIGN_EPI) { if (wr == 1) PG8_BAR; }
    }
    PG8_WAIT_V(0);
    if constexpr (!ALIGN_EPI) { if (wr == 0) PG8_BAR; }
    PG8_BAR;
    if constexpr (Epi::AFTER_DRAIN) { E.fused(acc, cur, wr, wc, fr, fq, lds, wid, lane); S.done(cur); }
#undef PG8_SA
#undef PG8_SB
#undef PG8_STAGE
#undef PG8_LDA
#undef PG8_LDB
#undef PG8_MMA
#undef PG8_WAIT_V
#undef PG8_WAIT_L
#undef PG8_BAR
#undef PG8_SCHED
}
}

constexpr int NWAVES = 8;
constexpr int M = 16384, D = 2048, FF = 5632, NIN = 10240;
constexpr float RMS_EPS = 1e-6f, LN_EPS = 1e-5f;
#ifndef MK_PER_PHASE
#define MK_PER_PHASE 0
#endif
constexpr int N_PHASES = 11;

constexpr size_t MiB = 1u << 20;
constexpr size_t WS_STATS = 0;
constexpr size_t WS_SLOTS = 4 * MiB;
constexpr size_t WS_WIN = 6 * MiB;
constexpr size_t WS_WBA = 46 * MiB, WS_WBB = 54 * MiB, WS_WOUT = 62 * MiB;
constexpr size_t WS_WPOOL = 70 * MiB;
constexpr size_t WS_W1 = 72 * MiB;
constexpr size_t WS_W1O = WS_W1 + 44 * MiB;
constexpr size_t WS_XN = 138 * MiB;
constexpr size_t WS_BIG = 202 * MiB;
constexpr size_t WS_W2 = 458 * MiB, WS_W2O = WS_W2 + 44 * MiB;
constexpr size_t WS_BAR = 524 * MiB, BAR_BYTES = 16384;
constexpr size_t WS_END = 524 * MiB + 65536;

constexpr int RING_BYTES = 131072, RSTD_OFF = RING_BYTES + 64, LDS_BYTES = 133120;

#define LAS __attribute__((address_space(3)))
typedef unsigned short bf16;
typedef unsigned v4u __attribute__((ext_vector_type(4)));
typedef unsigned v2u __attribute__((ext_vector_type(2)));
typedef float f32x4 __attribute__((ext_vector_type(4)));
typedef float f32x2 __attribute__((ext_vector_type(2)));
typedef short bf16x8 __attribute__((ext_vector_type(8)));
#define LDS_WAIT() asm volatile("s_waitcnt lgkmcnt(0)" ::: "memory")
__device__ __forceinline__ unsigned pk2(float lo, float hi) { return pg8::cvt_pk_bf16(lo, hi); }
__device__ __forceinline__ float wave_sum(float v) {
#pragma unroll
    for (int o = 1; o < 64; o <<= 1) v += __shfl_xor(v, o);
    return v;
}

struct TItem { const float* src; bf16* dst; const float* gain; int ldn, ldk; };
__device__ __forceinline__ void t_load(const TItem& t, f32x4 (&r)[8], int lane) {
    const float* p = t.src + (size_t)(lane >> 3) * t.ldn + (lane & 7) * 4;
#pragma unroll
    for (int i = 0; i < 8; ++i) r[i] = __builtin_nontemporal_load((const f32x4*)(p + (size_t)(8 * i) * t.ldn));
}
__device__ __forceinline__ void t_store(const TItem& t, const f32x4 (&r)[8], LAS float* scr, int lane) {
#pragma unroll
    for (int i = 0; i < 8; ++i) { const int kk = 8 * i + (lane >> 3); const float gs = t.gain ? t.gain[kk] : 1.0f; LAS float* d = scr + kk * 33 + (lane & 7) * 4;
        d[0] = r[i].x * gs; d[1] = r[i].y * gs; d[2] = r[i].z * gs; d[3] = r[i].w * gs; }
    LDS_WAIT(); asm volatile("" ::: "memory");
    const int c = lane & 7;
#pragma unroll
    for (int j = 0; j < 4; ++j) { const int n = (lane >> 3) + 8 * j; const LAS float* q = scr + (8 * c) * 33 + n;
        v4u o; o.x = pk2(q[0 * 33], q[1 * 33]); o.y = pk2(q[2 * 33], q[3 * 33]); o.z = pk2(q[4 * 33], q[5 * 33]); o.w = pk2(q[6 * 33], q[7 * 33]);
        *(v4u*)(t.dst + (size_t)n * t.ldk + 8 * c) = o; }
    LDS_WAIT(); asm volatile("" ::: "memory");
}
__device__ __forceinline__ TItem t_plain(const float* W, int K, int N, bf16* WT, int it, const float* gain) {
    const int nblk = N / 32, kb = it / nblk, nb = it % nblk; TItem t; t.src = W + (size_t)(64 * kb) * N + 32 * nb; t.dst = WT + (size_t)(32 * nb) * K + 64 * kb; t.gain = gain ? gain + 64 * kb : nullptr; t.ldn = N; t.ldk = K; return t;
}
__device__ __forceinline__ TItem t_swiglu(const float* W, bf16* WT, int it, const float* gain) {
    constexpr int nblk = 2 * FF / 32; const int kb = it / nblk, nb = it % nblk; int n0 = 32 * nb, up = 0; if (n0 >= FF) { n0 -= FF; up = 128; }
    TItem t; t.src = W + (size_t)(64 * kb) * (2 * FF) + 32 * nb; t.dst = WT + (size_t)(256 * (n0 >> 7) + up + (n0 & 127)) * D + 64 * kb; t.gain = gain ? gain + 64 * kb : nullptr; t.ldn = 2 * FF; t.ldk = D; return t;
}
constexpr int IT_FFN_IN = (D / 64) * (2 * FF / 32), IT_FFN_OUT = (FF / 64) * (D / 32), IT_WIN = (D / 64) * (NIN / 32), IT_DD = (D / 64) * (D / 32), IT_POOL = (512 / 64) * (512 / 32);

template <bool OUT_F32> __device__ __forceinline__ void rms_rows(const float* src, const float* gain, void* dst, int gw, int NGW, int lane) {
    if (gw >= M) return;
    f32x4 v[8], nv[8];
#pragma unroll
    for (int j = 0; j < 8; ++j) v[j] = __builtin_nontemporal_load((const f32x4*)(src + (size_t)gw * D) + lane + 64 * j);
    for (int m = gw; m < M; m += NGW) {
        if (m + NGW < M) {
#pragma unroll
            for (int j = 0; j < 8; ++j) nv[j] = __builtin_nontemporal_load((const f32x4*)(src + (size_t)(m + NGW) * D) + lane + 64 * j); }
        float s = 0.f;
#pragma unroll
        for (int j = 0; j < 8; ++j) s += (v[j].x * v[j].x + v[j].y * v[j].y) + (v[j].z * v[j].z + v[j].w * v[j].w);
        const float rstd = 1.0f / sqrtf(wave_sum(s) * (1.f / D) + RMS_EPS);
#pragma unroll
        for (int j = 0; j < 8; ++j) { const f32x4 g = ((const f32x4*)gain)[lane + 64 * j]; const f32x4 o = v[j] * rstd * g;
            if (OUT_F32) ((f32x4*)((float*)dst + (size_t)m * D))[lane + 64 * j] = o;
            else { v2u w; w.x = pk2(o.x, o.y); w.y = pk2(o.z, o.w); ((v2u*)((bf16*)dst + (size_t)m * D))[lane + 64 * j] = w; } }
#pragma unroll
        for (int j = 0; j < 8; ++j) v[j] = nv[j];
    }
}

constexpr int SGU_WM_OFF = 0, SGU_WM_PITCH = 272, SGU_VT_OFF = 128 * SGU_WM_PITCH, SGU_VT_PITCH = 520, SGU_ST_OFF = SGU_VT_OFF + 128 * SGU_VT_PITCH;
static_assert(SGU_ST_OFF + 1024 <= RING_BYTES, "SGU LDS map");
__device__ __forceinline__ void sgu_phase(LAS unsigned char* lds, bf16* U, const bf16* V, const float* stats, const float* ln_g, const float* ln_b, const float* w_s, const float* b_s, int G, int bid, const int wid) {
    int lane0 = (int)__builtin_amdgcn_mbcnt_hi(~0u, __builtin_amdgcn_mbcnt_lo(~0u, 0u)); asm volatile("" : "+v"(lane0));
    const int lane = lane0, tid = wid * 64 + lane, fr = lane & 15, fq = lane >> 4;
    const int h = bid & 7;
#pragma unroll
    for (int it = 0; it < 8; ++it) { const int q = it * 512 + tid, i = q >> 5, j4 = (q & 31) * 4; f32x4 w = *(const f32x4*)(w_s + (size_t)h * 16384 + i * 128 + j4);
        if (i < 64 && j4 >= 64) w = (f32x4){0.f, 0.f, 0.f, 0.f};
        v2u o; o.x = pk2(w.x, w.y); o.y = pk2(w.z, w.w); *(LAS v2u*)(lds + SGU_WM_OFF + i * SGU_WM_PITCH + j4 * 2) = o; }
    const int c8 = tid & 31; const f32x4 g0 = *(const f32x4*)(ln_g + h * 256 + c8 * 8), g1 = *(const f32x4*)(ln_g + h * 256 + c8 * 8 + 4), b0 = *(const f32x4*)(ln_b + h * 256 + c8 * 8), b1 = *(const f32x4*)(ln_b + h * 256 + c8 * 8 + 4);
    LAS float* smu = (LAS float*)(lds + SGU_ST_OFF); LAS float* srs = smu + 128;
    v4u vn[8]; f32x4 sn[4];
#define SGU_PREFETCH(unit_) do { const size_t rb_ = (size_t)((unit_) >> 3) * 128; \
        _Pragma("unroll") for (int it = 0; it < 8; ++it) vn[it] = *(const v4u*)(V + (rb_ + it * 16 + (tid >> 5)) * 2048 + h * 256 + c8 * 8); \
        _Pragma("unroll") for (int k = 0; k < 4; ++k) sn[k] = *(const f32x4*)(stats + (rb_ + (tid >> 2)) * 64 + (tid & 3) * 16 + 4 * k); } while (0)
    if (bid < 1024) SGU_PREFETCH(bid);
    for (int unit = bid; unit < 1024; unit += G) {
        const int nb = unit >> 3; const size_t rowbase = (size_t)nb * 128;
        { float s = 0.f, q = 0.f;
#pragma unroll
            for (int k = 0; k < 4; ++k) { s += sn[k].x + sn[k].z; q += sn[k].y + sn[k].w; }
            s += __shfl_xor(s, 1); q += __shfl_xor(q, 1); s += __shfl_xor(s, 2); q += __shfl_xor(q, 2);
            const float mean = s * (1.f / 2048.f), var = fmaxf(q * (1.f / 2048.f) - mean * mean, 0.f);
            if ((tid & 3) == 0) { smu[tid >> 2] = mean; srs[tid >> 2] = 1.0f / sqrtf(var + LN_EPS); } }
        __syncthreads();
#pragma unroll
        for (int it = 0; it < 8; ++it) { const int j = it * 16 + (tid >> 5); const v4u vw = vn[it]; const float mu = smu[j], rs = srs[j];
            f32x4 x0 = (f32x4){pg8::bf_lo(vw.x), pg8::bf_hi(vw.x), pg8::bf_lo(vw.y), pg8::bf_hi(vw.y)}, x1 = (f32x4){pg8::bf_lo(vw.z), pg8::bf_hi(vw.z), pg8::bf_lo(vw.w), pg8::bf_hi(vw.w)};
            x0 = (x0 - mu) * rs * g0 + b0; x1 = (x1 - mu) * rs * g1 + b1;
            LAS v2u* dst = (LAS v2u*)(lds + SGU_VT_OFF + j * SGU_VT_PITCH + c8 * 16); v2u o0, o1; o0.x = pk2(x0.x, x0.y); o0.y = pk2(x0.z, x0.w); o1.x = pk2(x1.x, x1.y); o1.y = pk2(x1.z, x1.w); dst[0] = o0; dst[1] = o1; }
        __syncthreads();
        v2u uw[8][2];
#pragma unroll
        for (int m = 0; m < 8; ++m)
#pragma unroll
            for (int n = 0; n < 2; ++n) uw[m][n] = *(const v2u*)(U + (rowbase + 16 * m + fr) * 2048 + h * 256 + 32 * wid + 16 * n + 4 * fq);
        if (unit + G < 1024) SGU_PREFETCH(unit + G);
        f32x4 acc[8][2];
#pragma unroll
        for (int m = 0; m < 8; ++m) { acc[m][0] = (f32x4){0.f, 0.f, 0.f, 0.f}; acc[m][1] = (f32x4){0.f, 0.f, 0.f, 0.f}; }
#pragma unroll 1
        for (int ks = 0; ks < 4; ++ks) {
            bf16x8 vf[2];
#pragma unroll
            for (int n = 0; n < 2; ++n) { const LAS bf16* vp = (const LAS bf16*)(lds + SGU_VT_OFF + (32 * ks + 8 * fq) * SGU_VT_PITCH + (32 * wid + 16 * n + fr) * 2);
#pragma unroll
                for (int e = 0; e < 8; ++e) vf[n][e] = (short)vp[e * (SGU_VT_PITCH / 2)]; }
#pragma unroll
            for (int m = 0; m < 8; ++m) { const bf16x8 wf = *(const LAS bf16x8*)(lds + SGU_WM_OFF + (16 * m + fr) * SGU_WM_PITCH + (32 * ks + 8 * fq) * 2);
                acc[m][0] = __builtin_amdgcn_mfma_f32_16x16x32_bf16(vf[0], wf, acc[m][0], 0, 0, 0); acc[m][1] = __builtin_amdgcn_mfma_f32_16x16x32_bf16(vf[1], wf, acc[m][1], 0, 0, 0); }
        }
#pragma unroll
        for (int m = 0; m < 8; ++m) { const int i = 16 * m + fr; const float bs = b_s[h * 128 + i];
#pragma unroll
            for (int n = 0; n < 2; ++n) { bf16* up = U + (rowbase + i) * 2048 + h * 256 + 32 * wid + 16 * n + 4 * fq; const v2u u2 = uw[m][n]; const f32x4 s = acc[m][n] + bs;
                v2u o; o.x = pk2(pg8::bf_lo(u2.x) * s.x, pg8::bf_hi(u2.x) * s.y); o.y = pk2(pg8::bf_lo(u2.y) * s.z, pg8::bf_hi(u2.y) * s.w); *(v2u*)up = o; } }
        __syncthreads();
    }
#undef SGU_PREFETCH
}
__device__ __forceinline__ void bf8_to_f(const v4u z, f32x4& a, f32x4& b) { a = (f32x4){pg8::bf_lo(z.x), pg8::bf_hi(z.x), pg8::bf_lo(z.y), pg8::bf_hi(z.y)}; b = (f32x4){pg8::bf_lo(z.z), pg8::bf_hi(z.z), pg8::bf_lo(z.w), pg8::bf_hi(z.w)}; }
__device__ __forceinline__ void pool_phase(const bf16* __restrict__ ZB, bf16* __restrict__ PO, int gtid, int gthreads) {
    for (int item = gtid; item < 512 * 256; item += gthreads) {
        const int c8 = item & 255, seg = item >> 8, w = 2 << (c8 >> 6), t0 = seg * 32; const bf16* zp = ZB + c8 * 8;
        f32x4 s0 = (f32x4){0.f, 0.f, 0.f, 0.f}, s1 = s0;
        { v4u z[16];
#pragma unroll
            for (int k = 0; k < 16; ++k) { const int t = t0 - 1 - k; z[k] = (k < w && t >= 0) ? *(const v4u*)(zp + (size_t)t * 2048) : (v4u){0u, 0u, 0u, 0u}; }
#pragma unroll
            for (int k = 0; k < 16; ++k) { f32x4 a, b; bf8_to_f(z[k], a, b); s0 += a; s1 += b; } }
#pragma unroll 1
        for (int blk = 0; blk < 4; ++blk) { v4u zc[8], zo[8];
#pragma unroll
            for (int k = 0; k < 8; ++k) { const int t = t0 + 8 * blk + k; zc[k] = *(const v4u*)(zp + (size_t)t * 2048); zo[k] = (t >= w) ? *(const v4u*)(zp + (size_t)(t - w) * 2048) : (v4u){0u, 0u, 0u, 0u}; }
#pragma unroll
            for (int k = 0; k < 8; ++k) { const int t = t0 + 8 * blk + k; f32x4 c0, c1, o0, o1; bf8_to_f(zc[k], c0, c1); bf8_to_f(zo[k], o0, o1);
                s0 += c0 - o0; s1 += c1 - o1;
                const float inv = 1.0f / (float)(t + 1 < w ? t + 1 : w); const f32x4 p0 = s0 * inv - c0, p1 = s1 * inv - c1;
                v4u o; o.x = pk2(p0.x, p0.y); o.y = pk2(p0.z, p0.w); o.z = pk2(p1.x, p1.y); o.w = pk2(p1.z, p1.w); *(v4u*)(PO + (size_t)t * 2048 + c8 * 8) = o; } }
    }
}

__device__ __forceinline__ void final_rows(const bf16* xn, const float* slots, const float* gain, float* out, int gw, int NGW, int lane) {
    if (gw >= M) return;
    v4u v[4], nv[4]; float sq, nsq = 0.f;
#pragma unroll
    for (int j = 0; j < 4; ++j) v[j] = __builtin_nontemporal_load((const v4u*)(xn + (size_t)gw * D) + lane + 64 * j);
    sq = slots[(size_t)gw * 32 + (lane & 31)];
    for (int m = gw; m < M; m += NGW) {
        if (m + NGW < M) {
#pragma unroll
            for (int j = 0; j < 4; ++j) nv[j] = __builtin_nontemporal_load((const v4u*)(xn + (size_t)(m + NGW) * D) + lane + 64 * j);
            nsq = slots[(size_t)(m + NGW) * 32 + (lane & 31)]; }
        const float rstd = 1.0f / sqrtf(wave_sum(sq) * (0.5f / D) + RMS_EPS);
#pragma unroll
        for (int j = 0; j < 4; ++j) { const int c = (lane + 64 * j) * 8; f32x4 a, b; bf8_to_f(v[j], a, b); const f32x4 g0 = *(const f32x4*)(gain + c), g1 = *(const f32x4*)(gain + c + 4);
            f32x4* o = (f32x4*)(out + (size_t)m * D + c); o[0] = a * rstd * g0; o[1] = b * rstd * g1; }
#pragma unroll
        for (int j = 0; j < 4; ++j) v[j] = nv[j];
        sq = nsq;
    }
}
#define XB_TMO      128
#define XB_XCNT(j)  (256  + 64 * (j))
#define XB_XSUB(j)  (1280 + 64 * (j))
#define XB_XGEN(j)  (2304 + 64 * (j))
#define XB_TOP      3328
#define XB_TOPGEN   3392
#define XCD_BAR_WORDS 3456
#define XB_SPIN_CAP (1u << 18)

__device__ __forceinline__ unsigned xb_ld(unsigned* p)              { return __hip_atomic_load(p, __ATOMIC_RELAXED, __HIP_MEMORY_SCOPE_AGENT); }
__device__ __forceinline__ unsigned xb_add(unsigned* p, unsigned v) { return __hip_atomic_fetch_add(p, v, __ATOMIC_RELAXED, __HIP_MEMORY_SCOPE_AGENT); }
__device__ __forceinline__ unsigned xb_xcc_id() { return (unsigned)__builtin_amdgcn_s_getreg((3 << 11) | 20) & 0xFu; }
#define XB_SPIN(cond, bar) do { unsigned _sp = 0; while (cond) { __builtin_amdgcn_s_sleep(1); \
    if ((++_sp & 255u) == 0u) { if (xb_ld(&(bar)[XB_TMO])) break; if (_sp > XB_SPIN_CAP) { atomicAdd(&(bar)[XB_TMO], 1u); break; } } } } while (0)

struct XcdBarrier {
    unsigned* bar; unsigned x;
    volatile LAS unsigned* st;
};

__device__ __forceinline__ XcdBarrier xcd_barrier_post(unsigned* bar, volatile LAS unsigned* st) {
    XcdBarrier b; b.bar = bar; b.x = xb_xcc_id(); b.st = st;
    if (threadIdx.x == 0) (void)xb_add(&bar[XB_XCNT(b.x)], 1u);
    return b;
}
__device__ __forceinline__ void xcd_barrier_complete(unsigned* bar, unsigned x, unsigned& nloc, unsigned& nx) {
    const unsigned G = gridDim.x * gridDim.y * gridDim.z;
    unsigned sum, cnt, mine, sp = 0u;
    for (;;) {
        sum = 0u; cnt = 0u; mine = 0u;
#pragma unroll
        for (unsigned j = 0; j < 16; ++j) { const unsigned c = xb_ld(&bar[XB_XCNT(j)]); sum += c; cnt += (c > 0u) ? 1u : 0u; mine = (j == x) ? c : mine; }
        if (sum == G) break;
        __builtin_amdgcn_s_sleep(1);
        if ((++sp & 255u) == 0u) { if (xb_ld(&bar[XB_TMO])) break; if (sp > XB_SPIN_CAP) { atomicAdd(&bar[XB_TMO], 1u); break; } }
    }
    nloc = mine > 0u ? mine : 1u; nx = cnt > 0u ? cnt : 1u;
}

__device__ __forceinline__ void xcd_barrier(const XcdBarrier& b) {
    asm volatile("s_waitcnt vmcnt(0)" ::: "memory");
    __syncthreads();
    if (threadIdx.x == 0) {
        unsigned* bar = b.bar;
        __builtin_amdgcn_s_waitcnt(0);
        unsigned nloc = b.st[0], nx = b.st[1];
        if (nloc == 0u) { xcd_barrier_complete(bar, b.x, nloc, nx); b.st[0] = nloc; b.st[1] = nx; }
        const unsigned old = xb_add(&bar[XB_XSUB(b.x)], 1u);
        const unsigned gen = old / nloc;
        if (old + 1u == (gen + 1u) * nloc) {
            __builtin_amdgcn_fence(__ATOMIC_RELEASE, "agent");
            asm volatile("s_waitcnt vmcnt(0)" ::: "memory");
            const unsigned og = xb_add(&bar[XB_TOP], 1u);
            const unsigned tg = og / nx;
            if (og + 1u == (tg + 1u) * nx) xb_add(&bar[XB_TOPGEN], 1u);
            else XB_SPIN(xb_ld(&bar[XB_TOPGEN]) == tg, bar);
            __builtin_amdgcn_fence(__ATOMIC_ACQUIRE, "agent");
            xb_add(&bar[XB_XGEN(b.x)], 1u);
            asm volatile("s_waitcnt vmcnt(0)" ::: "memory");
        } else {
            XB_SPIN(xb_ld(&bar[XB_XGEN(b.x)]) == gen, bar);
            __builtin_amdgcn_fence(__ATOMIC_ACQUIRE, "agent");
            asm volatile("s_waitcnt vmcnt(0)" ::: "memory");
        }
    }
    __syncthreads();
}

__device__ __forceinline__ void build_rstd_table(LAS unsigned char* lds, const float* slots, int pm, int t) {
    if (t < 256) { const f32x4* sp = (const f32x4*)(slots + ((size_t)pm * 256 + t) * 32); float q = 0.f;
#pragma unroll
        for (int k = 0; k < 8; ++k) { const f32x4 a = sp[k]; q += (a[0] + a[1]) + (a[2] + a[3]); }
        ((LAS float*)(lds + RSTD_OFF))[t] = 1.0f / sqrtf(q * (1.0f / 2048.0f) + RMS_EPS); }
    __syncthreads();
}
struct Args { const float* in[20]; float* out; unsigned char* ws; int ph_lo, ph_hi; };
__global__ void __launch_bounds__(NWAVES * 64, 2) mk_fwd(Args args) {
    extern __shared__ __attribute__((aligned(16))) unsigned char lds_raw[];
    LAS unsigned char* lds = (LAS unsigned char*)lds_raw;
    const int wave = __builtin_amdgcn_readfirstlane((int)threadIdx.x >> 6);
#define LANE() ((int)__builtin_amdgcn_mbcnt_hi(~0u, __builtin_amdgcn_mbcnt_lo(~0u, 0u)))
    const int G = gridDim.x, bid = blockIdx.x;
    const int gw = bid * NWAVES + wave, NGW = G * NWAVES;
#define PTRS() unsigned char* ws = args.ws; float* out = args.out; asm volatile("" : "+s"(ws), "+s"(out)); \
    bf16* Win_t = (bf16*)(ws + WS_WIN); bf16* Wba_t = (bf16*)(ws + WS_WBA); bf16* Wbb_t = (bf16*)(ws + WS_WBB); bf16* Wout_t = (bf16*)(ws + WS_WOUT); bf16* Wpool_t = (bf16*)(ws + WS_WPOOL); \
    bf16* W1i_t = (bf16*)(ws + WS_W1); bf16* W1o_t = (bf16*)(ws + WS_W1O); bf16* W2i_t = (bf16*)(ws + WS_W2); bf16* W2o_t = (bf16*)(ws + WS_W2O); bf16* XN = (bf16*)(ws + WS_XN); bf16* HID = (bf16*)(ws + WS_BIG); \
    bf16* U = (bf16*)(ws + WS_BIG); bf16* V = (bf16*)(ws + WS_BIG + 64 * MiB); bf16* ZB = (bf16*)(ws + WS_BIG + 128 * MiB); bf16* GA = (bf16*)(ws + WS_BIG + 192 * MiB); bf16* GB = (bf16*)(ws + WS_W1); \
    float* STATS = (float*)(ws + WS_STATS); float* SLOTS = (float*)(ws + WS_SLOTS); const float* x = args.in[0]; \
    (void)Win_t; (void)Wba_t; (void)Wbb_t; (void)Wout_t; (void)Wpool_t; (void)W1i_t; (void)W1o_t; (void)W2i_t; (void)W2o_t; (void)XN; (void)HID; (void)U; (void)V; (void)ZB; (void)GA; (void)GB; (void)STATS; (void)SLOTS; (void)x; (void)out
    const int lo = args.ph_lo, hi = args.ph_hi;
#ifndef PH_MASK
#define PH_MASK 0x7ff
#endif
#define IN(k) (((PH_MASK >> (k)) & 1) && lo <= (k) && (k) < hi)
    XcdBarrier xbar; xbar.bar = (unsigned*)(args.ws + WS_BAR); xbar.x = 0; xbar.st = (volatile LAS unsigned*)(lds + RING_BYTES);
    if (args.ph_hi - args.ph_lo > 1) { if (threadIdx.x < 2) xbar.st[threadIdx.x] = 0u; __syncthreads(); xbar = xcd_barrier_post(xbar.bar, xbar.st); }
    if (args.ph_hi > 1000) cg::this_grid().sync();
#define SEAM(k) do { if (IN(k) && IN((k) + 1)) xcd_barrier(xbar); } while (0)
    if (IN(0)) { PTRS(); const int lane = LANE(); LAS float* scr = (LAS float*)(lds + wave * 16384);
        constexpr int NIT = 2 * (IT_FFN_IN + IT_FFN_OUT) + IT_WIN + 3 * IT_DD + 4 * IT_POOL;
#define P0_ITEM(t, it_) do { int r = (it_); \
            if (r < IT_FFN_IN) { t = t_swiglu(args.in[2], W1i_t, r, nullptr); break; } r -= IT_FFN_IN; \
            if (r < IT_FFN_OUT) { t = t_plain(args.in[3], FF, D, W1o_t, r, nullptr); break; } r -= IT_FFN_OUT; \
            if (r < IT_FFN_IN) { t = t_swiglu(args.in[17], W2i_t, r, args.in[16]); break; } r -= IT_FFN_IN; \
            if (r < IT_FFN_OUT) { t = t_plain(args.in[18], FF, D, W2o_t, r, nullptr); break; } r -= IT_FFN_OUT; \
            if (r < IT_WIN) { t = t_plain(args.in[5], D, NIN, Win_t, r, args.in[4]); break; } r -= IT_WIN; \
            if (r < IT_DD) { t = t_plain(args.in[13], D, D, Wba_t, r, nullptr); break; } r -= IT_DD; \
            if (r < IT_DD) { t = t_plain(args.in[14], D, D, Wbb_t, r, nullptr); break; } r -= IT_DD; \
            if (r < IT_DD) { t = t_plain(args.in[15], D, D, Wout_t, r, nullptr); break; } r -= IT_DD; \
            { const int gp = r / IT_POOL; t = t_plain(args.in[11] + (size_t)gp * 512 * 512, 512, 512, Wpool_t + (size_t)gp * 512 * 512, r % IT_POOL, nullptr); } } while (0)
        if (gw < NIT) { TItem cur, nx; f32x4 rc[8], rn[8]; P0_ITEM(cur, gw); t_load(cur, rc, lane); nx = cur;
            if (gw + NGW < NIT) { P0_ITEM(nx, gw + NGW); t_load(nx, rn, lane); }
            for (int it = gw; it < NIT; it += NGW) { const int nit = it + 2 * NGW; TItem n2 = nx; f32x4 r2[8];
                if (nit < NIT) { P0_ITEM(n2, nit); t_load(n2, r2, lane); }
                t_store(cur, rc, scr, lane); cur = nx; nx = n2;
#pragma unroll
                for (int i = 0; i < 8; ++i) { rc[i] = rn[i]; rn[i] = r2[i]; } } }
#undef P0_ITEM
        rms_rows<false>(x, args.in[1], XN, gw, NGW, lane);
    }
    SEAM(0);
    if (IN(1)) { PTRS(); pg8::Gemm g{XN, W1i_t, M, 2 * FF, D, D, D, 0, 0}; pg8::StaticOrder S; S.init(M, 2 * FF, G, bid); pg8::EpiSwiglu<false> E{HID, FF, nullptr, nullptr, -1};
        pg8::gemm_phase<pg8::EpiSwiglu<false>, pg8::StaticOrder, true, true>(lds, g, S, E, wave); }
    SEAM(1);
    if (IN(2)) { PTRS(); pg8::Gemm g{HID, W1o_t, M, D, FF, FF, FF, 0, 0}; pg8::StaticOrder S; S.init(M, D, G, bid); pg8::EpiResidB<false> E{x, XN, SLOTS, 0.5f};
        pg8::gemm_phase<pg8::EpiResidB<false>, pg8::StaticOrder, true, true>(lds, g, S, E, wave); }
    SEAM(2);
    if (IN(3)) { PTRS(); pg8::Gemm g{XN, Win_t, M, NIN, D, D, D, 0, 0}; pg8::StaticOrder S; S.init(M, NIN, G, bid); pg8::Unit u0{0, 0}; S.next(0, u0); build_rstd_table(lds, SLOTS, u0.pm, wave * 64 + LANE());
        pg8::EpiProj E{U, V, ZB, GA, GB, args.in[6], STATS, SLOTS, (const LAS float*)(lds + RSTD_OFF), u0.pm};
        pg8::gemm_phase<pg8::EpiProj, pg8::StaticOrder, true, true>(lds, g, S, E, wave); }
    SEAM(3);
    if (IN(4)) { PTRS();
#ifndef NO_SGU
        sgu_phase(lds, U, V, STATS, args.in[7], args.in[8], args.in[9], args.in[10], G, bid, wave);
#endif
#ifndef NO_POOL
        pool_phase(ZB, (bf16*)out, (bid * NWAVES + wave) * 64 + LANE(), G * NWAVES * 64);
#endif
    }
    SEAM(4);
    if (IN(5)) { PTRS();
        { pg8::Gemm g{(const bf16*)out, Wpool_t, M, D, 512, D, 512, 1, 512}; pg8::StaticOrder S; S.init(M, D, G, bid); pg8::EpiScale E{V, args.in[12]};
          pg8::gemm_phase<pg8::EpiScale, pg8::StaticOrder, true, true>(lds, g, S, E, wave); }
        { pg8::Gemm g{U, Wba_t, M, D, D, D, D, 0, 0}; pg8::StaticOrder S; S.init(M, D, G, bid); pg8::EpiGate<false> E{GA, GA, GA};
          pg8::gemm_phase<pg8::EpiGate<false>, pg8::StaticOrder, true, true>(lds, g, S, E, wave); }
    }
    SEAM(5);
    if (IN(6)) { PTRS(); pg8::Gemm g{V, Wbb_t, M, D, D, D, D, 0, 0}; pg8::StaticOrder S; S.init(M, D, G, bid); pg8::EpiGate<true> E{GB, GA, GB};
        pg8::gemm_phase<pg8::EpiGate<true>, pg8::StaticOrder, true, true>(lds, g, S, E, wave); }
    SEAM(6);
    if (IN(7)) { PTRS(); pg8::Gemm g{GB, Wout_t, M, D, D, D, D, 0, 0}; pg8::StaticOrder S; S.init(M, D, G, bid); pg8::EpiResidB<true> E{nullptr, XN, SLOTS, 1.0f};
        pg8::gemm_phase<pg8::EpiResidB<true>, pg8::StaticOrder, true, true>(lds, g, S, E, wave); }
    SEAM(7);
    if (IN(8)) { PTRS(); pg8::Gemm g{XN, W2i_t, M, 2 * FF, D, D, D, 0, 0}; pg8::StaticOrder S; S.init(M, 2 * FF, G, bid); pg8::Unit u0{0, 0}; S.next(0, u0); build_rstd_table(lds, SLOTS, u0.pm, wave * 64 + LANE());
        pg8::EpiSwiglu<true> E{HID, FF, SLOTS, (const LAS float*)(lds + RSTD_OFF), u0.pm};
        pg8::gemm_phase<pg8::EpiSwiglu<true>, pg8::StaticOrder, true, true>(lds, g, S, E, wave); }
    SEAM(8);
    if (IN(9)) { PTRS(); pg8::Gemm g{HID, W2o_t, M, D, FF, FF, FF, 0, 0}; pg8::StaticOrder S; S.init(M, D, G, bid); pg8::EpiResidB<true> E{nullptr, XN, SLOTS, 0.5f};
        pg8::gemm_phase<pg8::EpiResidB<true>, pg8::StaticOrder, true, true>(lds, g, S, E, wave); }
    SEAM(9);
    if (IN(10)) { PTRS(); const int lane = LANE(); final_rows(XN, SLOTS, args.in[19], out, gw, NGW, lane); }
#undef IN
#undef SEAM
}

extern "C" void kernel_launch(void* const* d_in, const int* in_sizes, int n_in, void* d_out, int out_size, void* d_ws, size_t ws_size, hipStream_t stream) {
    static int grid = 0;
    if (grid == 0) {
        if (n_in != 20 || in_sizes[0] != M * D || out_size != M * D || ws_size < WS_END) { fprintf(stderr, "kernel_launch: unexpected shapes (n_in %d, in0 %d, out %d, ws %zu, need %zu); nothing launched\n", n_in, n_in > 0 ? in_sizes[0] : -1, out_size, ws_size, (size_t)WS_END); grid = -1; return; }
        int dev = 0, cus = 0, per_cu = 0;
        (void)hipGetDevice(&dev); (void)hipDeviceGetAttribute(&cus, hipDeviceAttributeMultiprocessorCount, dev);
        if (hipFuncSetAttribute((const void*)mk_fwd, hipFuncAttributeMaxDynamicSharedMemorySize, LDS_BYTES) != hipSuccess) { fprintf(stderr, "kernel_launch: hipFuncSetAttribute failed\n"); grid = -1; return; }
        if (hipOccupancyMaxActiveBlocksPerMultiprocessor(&per_cu, (const void*)mk_fwd, NWAVES * 64, LDS_BYTES) != hipSuccess || per_cu < 1) { fprintf(stderr, "kernel_launch: occupancy query says %d\n", per_cu); per_cu = 1; }
        (void)hipGetLastError();
        grid = cus * per_cu;
        if (grid % 8 != 0 || grid <= 0) { fprintf(stderr, "kernel_launch: grid %d not a multiple of 8\n", grid); grid = -1; return; }
    }
    if (grid < 0) return;
    if (hipMemsetAsync((char*)d_ws + WS_BAR, 0, BAR_BYTES, stream) != hipSuccess) { fprintf(stderr, "kernel_launch: memset of the barrier words failed\n"); return; }
    Args a{};
    for (int i = 0; i < 20; ++i) a.in[i] = (const float*)d_in[i];
    a.out = (float*)d_out; a.ws = (unsigned char*)d_ws;
#if MK_PER_PHASE
    for (int p = 0; p < N_PHASES; ++p) { a.ph_lo = p; a.ph_hi = p + 1; hipLaunchKernelGGL(mk_fwd, dim3(grid), dim3(NWAVES * 64), LDS_BYTES, stream, a); }
#else
    a.ph_lo = 0; a.ph_hi = N_PHASES;
    void* kargs[] = {&a};
    hipError_t e = hipLaunchCooperativeKernel((const void*)mk_fwd, dim3(grid), dim3(NWAVES * 64), kargs, LDS_BYTES, stream);
    if (e != hipSuccess) fprintf(stderr, "kernel_launch: cooperative launch failed: %s (grid %d)\n", hipGetErrorString(e), grid);
#endif
}
```
